# Optimizing an MI355X kernel written in HIP

```python
import math
import jax, jax.numpy as jnp
from jax import lax
import numpy as np

D_MODEL = 1024
BATCH = 8
SEQ = 4096
DEPTH = 2

MIX_WIDTH = D_MODEL
ATT_WIDTH = MIX_WIDTH // 2
FOURIER_WIDTH = MIX_WIDTH - ATT_WIDTH
N_HEADS = 8
HEAD_DIM = ATT_WIDTH // (2 * N_HEADS)
V_HEAD_DIM = 2 * HEAD_DIM
N_FGROUPS = 4
FGROUP_DIM = FOURIER_WIDTH // N_FGROUPS
IN_COLS = 3 * ATT_WIDTH + FOURIER_WIDTH
D_FF = ((8 * D_MODEL + 3 * 256 - 1) // (3 * 256)) * 256
Q_BLOCK = 128
LN_EPS = 1e-5
SUBLN_EPS = 1e-5
ALPHA = (2.0 * DEPTH) ** 0.25
BETA = (8.0 * DEPTH) ** -0.25
LAMBDA_STD = 0.1

kernel_name = 'hymba_diffattn_fnet_deepnorm_encoder'


def layer_norm(x, g, b):
    x32 = x.astype(jnp.float32)
    mu = jnp.mean(x32, axis=-1, keepdims=True)
    var = jnp.mean(jnp.square(x32 - mu), axis=-1, keepdims=True)
    return ((x32 - mu) * lax.rsqrt(var + LN_EPS) * g + b).astype(x.dtype)


def lambda_init_fn(layer_idx):
    return 0.8 - 0.6 * math.exp(-0.3 * layer_idx)


def diff_attention(q, k, v, lam, lam_init, subln_g):
    B, S = q.shape[0], q.shape[1]
    nb = S // Q_BLOCK
    slopes = jnp.exp2(-8.0 * jnp.arange(1, N_HEADS + 1, dtype=jnp.float32) / N_HEADS)
    kpos = jnp.arange(S, dtype=jnp.float32)
    scale = HEAD_DIM ** -0.5
    qb = q.reshape(B, nb, Q_BLOCK, N_HEADS, 2, HEAD_DIM).transpose(1, 0, 2, 3, 4, 5)
    starts = jnp.arange(nb, dtype=jnp.float32) * Q_BLOCK

    def block(args):
        qi, start = args
        s = jnp.einsum('bqhcd,bkhcd->bhcqk', qi, k).astype(jnp.float32) * scale
        qpos = start + jnp.arange(Q_BLOCK, dtype=jnp.float32)
        dist = jnp.abs(qpos[:, None] - kpos[None, :])
        s = s - slopes[:, None, None, None] * dist[None, None]
        p = jax.nn.softmax(s, axis=-1)
        a = p[:, :, 0] - lam * p[:, :, 1]
        o = jnp.einsum('bhqk,bkhd->bqhd', a.astype(v.dtype), v).astype(jnp.float32)
        o = o * lax.rsqrt(jnp.mean(jnp.square(o), axis=-1, keepdims=True) + SUBLN_EPS)
        o = o * subln_g * (1.0 - lam_init)
        return o.astype(v.dtype)

    out = lax.map(block, (qb, starts))
    return out.transpose(1, 0, 2, 3, 4).reshape(B, S, N_HEADS * V_HEAD_DIM)


def fourier_mix(u, w_f, b_f):
    B, S = u.shape[0], u.shape[1]
    ug = u.reshape(B, S, N_FGROUPS, FGROUP_DIM).astype(jnp.float32)
    f = jnp.fft.fft(ug, axis=3, norm='ortho')
    f = jnp.fft.fft(f, axis=1, norm='ortho').real.astype(u.dtype)
    y = jnp.einsum('bsgc,gcd->bsgd', f, w_f)
    return y.reshape(B, S, FOURIER_WIDTH) + b_f


def swiglu(h, w_gu, w_down):
    gu = jnp.einsum('bsd,df->bsf', h, w_gu)
    g, up = gu[..., :D_FF], gu[..., D_FF:]
    return jnp.einsum('bsf,fd->bsd', jax.nn.silu(g) * up, w_down)


def setup_inputs(seed: int = 0) -> dict:
    key = jax.random.key(seed)
    ks = jax.random.split(key, 16)
    f32 = jnp.float32
    nrm = lambda k, shape: jax.random.normal(k, shape, f32)
    return {
        'x': nrm(ks[0], (BATCH, SEQ, D_MODEL)),
        'ln_in_g': 1.0 + 0.01 * nrm(ks[1], (D_MODEL,)),
        'ln_in_b': 0.01 * nrm(ks[2], (D_MODEL,)),
        'w_in': nrm(ks[3], (DEPTH, D_MODEL, IN_COLS)) * D_MODEL ** -0.5,
        'lam_params': LAMBDA_STD * nrm(ks[4], (DEPTH, 4, HEAD_DIM)),
        'subln_g': 1.0 + 0.01 * nrm(ks[5], (DEPTH, V_HEAD_DIM)),
        'w_f': nrm(ks[6], (DEPTH, N_FGROUPS, FGROUP_DIM, FGROUP_DIM)) * FGROUP_DIM ** -0.5,
        'b_f': 0.01 * nrm(ks[7], (DEPTH, FOURIER_WIDTH)),
        'w_o': nrm(ks[8], (DEPTH, MIX_WIDTH, D_MODEL)) * (MIX_WIDTH ** -0.5 * BETA),
        'ln1_g': 1.0 + 0.01 * nrm(ks[9], (DEPTH, D_MODEL)),
        'ln1_b': 0.01 * nrm(ks[10], (DEPTH, D_MODEL)),
        'w_gu': nrm(ks[11], (DEPTH, D_MODEL, 2 * D_FF)) * D_MODEL ** -0.5,
        'w_down': nrm(ks[12], (DEPTH, D_FF, D_MODEL)) * (D_FF ** -0.5 * BETA),
        'ln2_g': 1.0 + 0.01 * nrm(ks[13], (DEPTH, D_MODEL)),
        'ln2_b': 0.01 * nrm(ks[14], (DEPTH, D_MODEL)),
    }


def reference(x, ln_in_g, ln_in_b, w_in, lam_params, subln_g, w_f, b_f, w_o,
              ln1_g, ln1_b, w_gu, w_down, ln2_g, ln2_b):
    B, S = x.shape[0], x.shape[1]
    h = layer_norm(x, ln_in_g, ln_in_b)
    for l in range(DEPTH):
        lam_init = lambda_init_fn(l)
        proj = jnp.einsum('bsd,de->bse', h, w_in[l])
        q = proj[..., :ATT_WIDTH].reshape(B, S, N_HEADS, 2, HEAD_DIM)
        k = proj[..., ATT_WIDTH:2 * ATT_WIDTH].reshape(B, S, N_HEADS, 2, HEAD_DIM)
        v = proj[..., 2 * ATT_WIDTH:3 * ATT_WIDTH].reshape(B, S, N_HEADS, V_HEAD_DIM)
        u = proj[..., 3 * ATT_WIDTH:]
        lp = lam_params[l].astype(jnp.float32)
        lam = jnp.exp(jnp.sum(lp[0] * lp[1])) - jnp.exp(jnp.sum(lp[2] * lp[3])) + lam_init
        a = diff_attention(q, k, v, lam, lam_init, subln_g[l])
        f = fourier_mix(u, w_f[l], b_f[l])
        mix = jnp.einsum('bse,ed->bsd', jnp.concatenate([a, f], axis=-1), w_o[l])
        h = layer_norm(ALPHA * h + mix, ln1_g[l], ln1_b[l])
        h = layer_norm(ALPHA * h + swiglu(h, w_gu[l], w_down[l]), ln2_g[l], ln2_b[l])
    return h
```

```cpp
#include <hip/hip_runtime.h>
#include <hip/hip_cooperative_groups.h>
#include <cstdio>
#include <cstdint>
namespace cg = cooperative_groups;
namespace pg8 {
#define PG8_LAS __attribute__((address_space(3)))
typedef unsigned short bf16_t;
typedef short bf16x8 __attribute__((ext_vector_type(8)));
typedef float f32x4 __attribute__((ext_vector_type(4)));
typedef unsigned u32x4 __attribute__((ext_vector_type(4)));
constexpr int BM = 256, BK = 64, HALF = 128, HTB = HALF * BK * 2  , STAGE_BYTES = 8 * HTB, NXCD = 8, WGM = 8;

__host__ __device__ __forceinline__ int lds_byte(int r, int c) { const int st = (r >> 4) * 2 + (c >> 5), rr = r & 15, cc = c & 31, ob = rr * 64 + cc * 2; return st * 1024 + (ob ^ (((ob >> 9) & 1) << 5)); }
__host__ __device__ __forceinline__ void stage_rc(int b, int& R, int& C) { const int st = b / 1024, sb = b % 1024, swz = sb ^ (((sb >> 9) & 1) << 5); R = (st >> 1) * 16 + swz / 64; C = (st & 1) * 32 + (swz % 64) / 2; }
__host__ __device__ __forceinline__ int perm32(int rho) { const int n = rho >> 4, i = rho & 15; return 8 * (i >> 2) + 4 * n + (i & 3); }

struct Unit { int pm, pn; };
struct Gemm { const bf16_t* A; const bf16_t* Bt; int M, N, K; };

struct StaticOrder {
    int nM, nN, nwg, G, c;
    __host__ __device__ void init(int M, int N, int G_, int c_) { nM = M / BM; nN = N / BM; nwg = nM * nN; G = G_; c = c_; }
    __host__ __device__ bool next(int i, Unit& u) const {
        const long L = (long)i * G + c; if (L >= nwg) return false;
        int wgid = (int)L; { const int q = nwg / NXCD, r = nwg % NXCD, xcd = wgid % NXCD, off = wgid / NXCD; wgid = (xcd < r ? xcd * (q + 1) : r * (q + 1) + (xcd - r) * q) + off; }
        const int nig = WGM * nN, gid = wgid / nig, fm = gid * WGM, gsz = (nM - fm) < WGM ? (nM - fm) : WGM;
        u.pm = fm + ((wgid % nig) % gsz); u.pn = (wgid % nig) / gsz; return true;
    }
    __device__ __forceinline__ void a_ready(const Unit&) const {}
    __device__ __forceinline__ void done(const Unit&) const {}
};

__device__ __forceinline__ unsigned cvt_pk_bf16(float lo, float hi) { unsigned r; asm volatile("v_cvt_pk_bf16_f32 %0, %1, %2" : "=v"(r) : "v"(lo), "v"(hi)); return r; }
typedef float f32x2 __attribute__((ext_vector_type(2)));

struct EpiBf16 {
    static constexpr bool PERM = true, AFTER_DRAIN = false;
    bf16_t* O; int ldc; int split_cols; size_t split_stride;
    __device__ __forceinline__ void operator()(const f32x4 (&acc)[2][2][4][2], const Unit& u, int wr, int wc, int fr, int fq) const {
        const int row0 = u.pm * BM + wr * 64 + fr; int colt = u.pn * BM; bf16_t* base = O;
        if (split_cols) { const int t = colt / split_cols; base += (size_t)t * split_stride; colt -= t * split_cols; }
        const int col0 = colt + wc * 32 + 8 * fq;
#pragma unroll
        for (int ai = 0; ai < 2; ++ai)
#pragma unroll
            for (int m = 0; m < 4; ++m) { bf16_t* rowp = base + (size_t)(row0 + ai * HALF + m * 16) * ldc + col0;
#pragma unroll
                for (int bj = 0; bj < 2; ++bj) { const f32x4 v0 = acc[ai][bj][m][0], v1 = acc[ai][bj][m][1];
                    u32x4 w; w.x = cvt_pk_bf16(v0[0], v0[1]); w.y = cvt_pk_bf16(v0[2], v0[3]); w.z = cvt_pk_bf16(v1[0], v1[1]); w.w = cvt_pk_bf16(v1[2], v1[3]);
                    *(u32x4*)(rowp + bj * HALF) = w; } }
    }
};
struct EpiDft {
    static constexpr bool PERM = true, AFTER_DRAIN = false;
    bf16_t* O;
    __device__ __forceinline__ void operator()(const f32x4 (&acc)[2][2][4][2], const Unit& u, int wr, int wc, int fr, int fq) const {
        const int row0 = (u.pn >> 1) * 4096 + u.pm * BM + wr * 64 + fr; const int col0 = 512 + (u.pn & 1) * 256 + wc * 32 + 8 * fq;
#pragma unroll
        for (int ai = 0; ai < 2; ++ai)
#pragma unroll
            for (int m = 0; m < 4; ++m) { bf16_t* rowp = O + (size_t)(row0 + ai * HALF + m * 16) * 1024 + col0;
#pragma unroll
                for (int bj = 0; bj < 2; ++bj) { const f32x4 v0 = acc[ai][bj][m][0], v1 = acc[ai][bj][m][1];
                    u32x4 w; w.x = cvt_pk_bf16(v0[0], v0[1]); w.y = cvt_pk_bf16(v0[2], v0[3]); w.z = cvt_pk_bf16(v1[0], v1[1]); w.w = cvt_pk_bf16(v1[2], v1[3]);
                    *(u32x4*)(rowp + bj * HALF) = w; } }
    }
};
struct EpiSwiGLU {
    static constexpr bool PERM = true, AFTER_DRAIN = false;
    bf16_t* O; int ldc;
    __device__ __forceinline__ static float sw(float g, float up) { const float e = __builtin_amdgcn_exp2f(g * -1.4426950408889634f); return g * up * __builtin_amdgcn_rcpf(1.0f + e); }
    __device__ __forceinline__ void operator()(const f32x4 (&acc)[2][2][4][2], const Unit& u, int wr, int wc, int fr, int fq) const {
        const int row0 = u.pm * BM + wr * 64 + fr; const int col0 = u.pn * HALF + wc * 32 + 8 * fq;
#pragma unroll
        for (int ai = 0; ai < 2; ++ai)
#pragma unroll
            for (int m = 0; m < 4; ++m) { bf16_t* rowp = O + (size_t)(row0 + ai * HALF + m * 16) * ldc + col0;
                const f32x4 g0 = acc[ai][0][m][0], g1 = acc[ai][0][m][1], u0 = acc[ai][1][m][0], u1 = acc[ai][1][m][1];
                u32x4 w; w.x = cvt_pk_bf16(sw(g0[0], u0[0]), sw(g0[1], u0[1])); w.y = cvt_pk_bf16(sw(g0[2], u0[2]), sw(g0[3], u0[3]));
                w.z = cvt_pk_bf16(sw(g1[0], u1[0]), sw(g1[1], u1[1])); w.w = cvt_pk_bf16(sw(g1[2], u1[2]), sw(g1[3], u1[3]));
                *(u32x4*)rowp = w; }
    }
};
struct EpiPre {
    static constexpr bool PERM = false, AFTER_DRAIN = false;
    const float* H; float* PRE; const float* bias; float alpha;
    __device__ __forceinline__ void operator()(const f32x4 (&acc)[2][2][4][2], const Unit& u, int wr, int wc, int fr, int fq) const {
        const int col0 = u.pn * BM + wc * 32 + 4 * fq;
#pragma unroll
        for (int ai = 0; ai < 2; ++ai)
#pragma unroll
            for (int m = 0; m < 4; ++m) { const size_t off = (size_t)(u.pm * BM + ai * HALF + wr * 64 + m * 16 + fr) * 1024 + col0;
#pragma unroll
                for (int bj = 0; bj < 2; ++bj)
#pragma unroll
                    for (int n = 0; n < 2; ++n) { const int cc = bj * HALF + n * 16;
                        const f32x4 hb = *(const f32x4*)(H + off + cc); f32x4 o = hb * alpha + acc[ai][bj][m][n];
                        if (bias) o += *(const f32x4*)(bias + col0 + cc);
                        *(f32x4*)(PRE + off + cc) = o; } }
    }
};
template <class Epi, class Sched, bool ALIGN_EPI = false, bool SP2 = false>
__device__ __forceinline__ void gemm_phase(PG8_LAS unsigned char* lds, const Gemm g, const Sched& S, const Epi& E) {
    int tid_ = threadIdx.x; asm volatile("" : "+v"(tid_));
    const int tid = tid_, wid = __builtin_amdgcn_readfirstlane(tid >> 6), lane = tid & 63, wr = wid >> 2, wc = wid & 3, fr = lane & 15, fq = lane >> 4;
    const int K = g.K, nt = K / BK;
    unsigned voffA[2], voffB[2];
#pragma unroll
    for (int i = 0; i < 2; ++i) { int R, C; stage_rc(tid * 16 + i * 8192, R, C); const int Rb = Epi::PERM ? ((R & ~31) + perm32(R & 31)) : R;
        voffA[i] = (unsigned)(R * K + C) * 2u; voffB[i] = (unsigned)(Rb * K + C) * 2u; }
    const size_t kstep = (size_t)(BK * 2);
    const size_t hstep = (size_t)HALF * K * 2;
    const size_t tstep = 2 * hstep;
    const unsigned ldsw = (unsigned)wid * 1024u;
    const int aoff = lds_byte(wr * 64 + fr, fq * 8), boff = lds_byte(wc * 32 + fr, fq * 8);
#define PG8_SA(b, h) (((b) * 2 + (h)) * HTB)
#define PG8_SB(b, h) ((4 + (b) * 2 + (h)) * HTB)
#define PG8_STAGE(bufoff, gbase, voff) do { _Pragma("unroll") for (int _i = 0; _i < 2; ++_i) \
        __builtin_amdgcn_global_load_lds((const unsigned*)((const char*)(gbase) + (voff)[_i]), (PG8_LAS unsigned*)(lds + (bufoff) + ldsw + _i * 8192), 16, 0, 0); } while (0)
#define PG8_LDA(dst, b, h) do { _Pragma("unroll") for (int m = 0; m < 4; ++m) _Pragma("unroll") for (int k = 0; k < 2; ++k) dst[m][k] = *(const PG8_LAS bf16x8*)(lds + PG8_SA(b, h) + aoff + m * 2048 + k * 1024); } while (0)
#define PG8_LDB(dst, b, h) do { _Pragma("unroll") for (int n = 0; n < 2; ++n) _Pragma("unroll") for (int k = 0; k < 2; ++k) dst[n][k] = *(const PG8_LAS bf16x8*)(lds + PG8_SB(b, h) + boff + n * 2048 + k * 1024); } while (0)
#define PG8_MMA(ai, bj, At, Bt) do { __builtin_amdgcn_s_setprio(1); _Pragma("unroll") for (int m = 0; m < 4; ++m) _Pragma("unroll") for (int n = 0; n < 2; ++n) _Pragma("unroll") for (int k = 0; k < 2; ++k) \
        acc[ai][bj][m][n] = __builtin_amdgcn_mfma_f32_16x16x32_bf16(Bt[n][k], At[m][k], acc[ai][bj][m][n], 0, 0, 0); __builtin_amdgcn_s_setprio(0); } while (0)
#define PG8_WAIT_V(n) asm volatile("s_waitcnt vmcnt(" #n ")" ::: "memory")
#define PG8_WAIT_L(n) asm volatile("s_waitcnt lgkmcnt(" #n ")" ::: "memory")
#define PG8_BAR __builtin_amdgcn_s_barrier()
#define PG8_SCHED __builtin_amdgcn_sched_barrier(0)
    Unit cur, nxt; int ui = 0;
    if (!S.next(0, cur)) return;
    f32x4 acc[2][2][4][2];
#pragma unroll
    for (int a = 0; a < 2; ++a)
#pragma unroll
        for (int b = 0; b < 2; ++b)
#pragma unroll
            for (int m = 0; m < 4; ++m)
#pragma unroll
                for (int n = 0; n < 2; ++n) acc[a][b][m][n] = (f32x4){0.f, 0.f, 0.f, 0.f};
    bf16x8 At[4][2], B0[2][2], B1[2][2];
    const char* cA = (const char*)g.A + (size_t)cur.pm * tstep; const char* cB = (const char*)g.Bt + (size_t)cur.pn * tstep;
    S.a_ready(cur);
    if constexpr (SP2) {
        PG8_STAGE(PG8_SB(0, 0), cB, voffB); PG8_STAGE(PG8_SB(0, 1), cB + hstep, voffB); PG8_STAGE(PG8_SA(0, 0), cA, voffA); PG8_STAGE(PG8_SA(0, 1), cA + hstep, voffA);
        if (wr == 1) PG8_BAR;
        PG8_WAIT_V(2); PG8_BAR;
        PG8_STAGE(PG8_SB(1, 0), cB + kstep, voffB); PG8_STAGE(PG8_SA(1, 0), cA + kstep, voffA); PG8_STAGE(PG8_SB(1, 1), cB + hstep + kstep, voffB);
        PG8_WAIT_V(6); PG8_BAR;
    } else {
        PG8_STAGE(PG8_SB(0, 0), cB, voffB); PG8_STAGE(PG8_SA(0, 0), cA, voffA); PG8_STAGE(PG8_SB(0, 1), cB + hstep, voffB); PG8_STAGE(PG8_SA(0, 1), cA + hstep, voffA);
        if (wr == 1) PG8_BAR;
        PG8_WAIT_V(4); PG8_BAR;
        PG8_STAGE(PG8_SB(1, 0), cB + kstep, voffB); PG8_STAGE(PG8_SA(1, 0), cA + kstep, voffA); PG8_STAGE(PG8_SB(1, 1), cB + hstep + kstep, voffB);
        PG8_WAIT_V(6); PG8_BAR;
    }
    for (;;) {
        const bool has_next = S.next(ui + 1, nxt);
        const char* nA = has_next ? (const char*)g.A + (size_t)nxt.pm * tstep : cA; const char* nB = has_next ? (const char*)g.Bt + (size_t)nxt.pn * tstep : cB;
        for (int t = 0; t < nt; t += 2) {
            const bool last = (t == nt - 2);
            const char* a1 = cA + (size_t)(t + 1) * kstep;
            const char* a2 = last ? nA : cA + (size_t)(t + 2) * kstep; const char* b2 = last ? nB : cB + (size_t)(t + 2) * kstep;
            const char* a3 = a2 + kstep; const char* b3 = b2 + kstep;
            if (last && has_next) S.a_ready(nxt);
            if constexpr (SP2) {
            PG8_LDB(B0, 0, 0); PG8_LDB(B1, 0, 1); PG8_SCHED; PG8_LDA(At, 0, 0); PG8_STAGE(PG8_SA(1, 1), a1 + hstep, voffA);
            PG8_WAIT_V(8); PG8_WAIT_L(0); PG8_BAR; PG8_MMA(0, 0, At, B0); PG8_MMA(0, 1, At, B1); PG8_BAR; PG8_SCHED;
            PG8_LDA(At, 0, 1); PG8_STAGE(PG8_SB(0, 0), b2, voffB); PG8_STAGE(PG8_SB(0, 1), b2 + hstep, voffB); PG8_STAGE(PG8_SA(0, 0), a2, voffA);
            PG8_WAIT_V(8); PG8_WAIT_L(0); PG8_BAR; PG8_MMA(1, 0, At, B0); PG8_MMA(1, 1, At, B1); PG8_BAR; PG8_SCHED;
            PG8_LDB(B0, 1, 0); PG8_LDB(B1, 1, 1); PG8_SCHED; PG8_LDA(At, 1, 0); PG8_STAGE(PG8_SA(0, 1), a2 + hstep, voffA);
            PG8_WAIT_V(8); PG8_WAIT_L(0); PG8_BAR; PG8_MMA(0, 0, At, B0); PG8_MMA(0, 1, At, B1); PG8_BAR; PG8_SCHED;
            PG8_LDA(At, 1, 1); PG8_STAGE(PG8_SB(1, 0), b3, voffB); PG8_STAGE(PG8_SB(1, 1), b3 + hstep, voffB); PG8_STAGE(PG8_SA(1, 0), a3, voffA);
            PG8_WAIT_V(8); PG8_WAIT_L(0); PG8_BAR; PG8_MMA(1, 0, At, B0); PG8_MMA(1, 1, At, B1); PG8_BAR; PG8_SCHED;
            } else {
            PG8_LDB(B0, 0, 0); PG8_SCHED; PG8_LDA(At, 0, 0); PG8_STAGE(PG8_SA(1, 1), a1 + hstep, voffA);
            PG8_WAIT_L(8); PG8_BAR; PG8_WAIT_L(0); PG8_MMA(0, 0, At, B0); PG8_BAR; PG8_SCHED;
            PG8_LDB(B1, 0, 1); PG8_STAGE(PG8_SB(0, 0), b2, voffB);
            PG8_BAR; PG8_WAIT_L(0); PG8_MMA(0, 1, At, B1); PG8_BAR;
            PG8_LDA(At, 0, 1); PG8_STAGE(PG8_SA(0, 0), a2, voffA);
            PG8_BAR; PG8_WAIT_L(0); PG8_MMA(1, 0, At, B0); PG8_BAR; PG8_SCHED;
            PG8_STAGE(PG8_SB(0, 1), b2 + hstep, voffB);
            PG8_WAIT_V(6); PG8_BAR; PG8_MMA(1, 1, At, B1); PG8_BAR;
            PG8_LDB(B0, 1, 0); PG8_SCHED; PG8_LDA(At, 1, 0); PG8_STAGE(PG8_SA(0, 1), a2 + hstep, voffA);
            PG8_WAIT_L(8); PG8_BAR; PG8_WAIT_L(0); PG8_MMA(0, 0, At, B0); PG8_BAR; PG8_SCHED;
            PG8_LDB(B1, 1, 1); PG8_STAGE(PG8_SB(1, 0), b3, voffB);
            PG8_BAR; PG8_WAIT_L(0); PG8_MMA(0, 1, At, B1); PG8_BAR;
            PG8_LDA(At, 1, 1); PG8_STAGE(PG8_SA(1, 0), a3, voffA);
            PG8_BAR; PG8_WAIT_L(0); PG8_MMA(1, 0, At, B0); PG8_BAR; PG8_SCHED;
            PG8_STAGE(PG8_SB(1, 1), b3 + hstep, voffB);
            PG8_WAIT_V(6); PG8_BAR; PG8_MMA(1, 1, At, B1); PG8_BAR;
            }
        }
        if constexpr (ALIGN_EPI) { if (wr == 0) PG8_BAR; }
        if constexpr (!Epi::AFTER_DRAIN) { E(acc, cur, wr, wc, fr, fq); S.done(cur); }
        if (!has_next) break;
#pragma unroll
        for (int a = 0; a < 2; ++a)
#pragma unroll
            for (int b = 0; b < 2; ++b)
#pragma unroll
                for (int m = 0; m < 4; ++m)
#pragma unroll
                    for (int n = 0; n < 2; ++n) acc[a][b][m][n] = (f32x4){0.f, 0.f, 0.f, 0.f};
        cur = nxt; cA = nA; cB = nB; ++ui;
        if constexpr (ALIGN_EPI) { if (wr == 1) PG8_BAR; }
    }
    PG8_WAIT_V(0);
    if constexpr (!ALIGN_EPI) { if (wr == 0) PG8_BAR; }
    PG8_BAR;
    if constexpr (Epi::AFTER_DRAIN) { E.fused(acc, cur, wr, wc, fr, fq, lds, wid, lane); S.done(cur); }
#undef PG8_SA
#undef PG8_SB
#undef PG8_STAGE
#undef PG8_LDA
#undef PG8_LDB
#undef PG8_MMA
#undef PG8_WAIT_V
#undef PG8_WAIT_L
#undef PG8_BAR
#undef PG8_SCHED
}
}
constexpr int BATCH = 8, SEQ = 4096, DM = 1024, DEPTH = 2, MTOK = BATCH * SEQ;
constexpr int NQKV = 1536, NU2 = 1024, FF = 2816, NGU = 2 * FF, NHEAD = 8;
constexpr float LN_EPS = 1e-5f, SUBLN_EPS = 1e-5f;
constexpr float ALPHA = 1.4142135623730951f;
constexpr float QSCALE = 0.17677669529663687f * 1.4426950408889634f;
constexpr int NWAVES = 8, NTHREADS = 512;

typedef unsigned short bf16_t;
typedef short bf16x8 __attribute__((ext_vector_type(8)));
typedef short s16x4 __attribute__((ext_vector_type(4)));
typedef float f32x4 __attribute__((ext_vector_type(4)));
typedef float f32x16 __attribute__((ext_vector_type(16)));
typedef unsigned u32x4 __attribute__((ext_vector_type(4)));
typedef unsigned u32x2 __attribute__((ext_vector_type(2)));
#define LAS __attribute__((address_space(3)))

constexpr size_t MiB = 1u << 20;
constexpr size_t WS_CTL = 0;
constexpr size_t WS_W = 2 * MiB, W_LAYER = 24 * MiB;
constexpr size_t W_QKV = 0, W_U = 3 * MiB, W_O = 5 * MiB, W_GU = 7 * MiB, W_D = 18 * MiB, W_BO = 23 * MiB + 512 * 1024;
constexpr size_t WS_DMAT = 50 * MiB;
constexpr size_t WS_XN = 114 * MiB;
constexpr size_t WS_H = 178 * MiB;
constexpr size_t WS_QKV = 306 * MiB;
constexpr size_t WS_XT = 402 * MiB;
constexpr size_t WS_ACT = 306 * MiB;
constexpr size_t WS_END = 482 * MiB;

struct Args { const float* in[15]; float* out; unsigned char* ws; };

__device__ __forceinline__ unsigned f2bf(float f) { unsigned u = __builtin_bit_cast(unsigned, f); return (u + 0x7fffu + ((u >> 16) & 1u)) >> 16; }
__device__ __forceinline__ unsigned pk2(float lo, float hi) { return f2bf(lo) | (f2bf(hi) << 16); }
__device__ __forceinline__ float wave_sum(float v) {
#pragma unroll
    for (int o = 1; o < 64; o <<= 1) v += __shfl_xor(v, o);
    return v;
}

__device__ __forceinline__ void tr_item(const float* W, int ldw, bf16_t* WT, int ldt, int k0, int n0, int mode, float scale, LAS float* scr, int lane) {
#pragma unroll 8
    for (int i = 0; i < 32; ++i) { const int kk = 2 * i + (lane >> 5); scr[kk * 33 + (lane & 31)] = W[(size_t)(k0 + kk) * ldw + n0 + (lane & 31)] * scale; }
    asm volatile("s_waitcnt lgkmcnt(0)" ::: "memory");
    int r0 = n0;
    if (mode == 1) { const int part = n0 >= FF ? 1 : 0; const int ff = n0 - part * FF; r0 = (ff >> 7) * 256 + part * 128 + (ff & 127); }
    const int c = lane & 7;
#pragma unroll
    for (int j = 0; j < 4; ++j) { const int n = (lane >> 3) + 8 * j; const LAS float* s = scr + (8 * c) * 33 + n;
        u32x4 o; o.x = pk2(s[0 * 33], s[1 * 33]); o.y = pk2(s[2 * 33], s[3 * 33]); o.z = pk2(s[4 * 33], s[5 * 33]); o.w = pk2(s[6 * 33], s[7 * 33]);
        *(u32x4*)(WT + (size_t)(r0 + n) * ldt + k0 + 8 * c) = o; }
    asm volatile("s_waitcnt lgkmcnt(0)" ::: "memory");
}
__device__ __forceinline__ void ln_row(const float* src, const float* g, const float* bta, float* dstf, bf16_t* dstb, int lane) {
    const f32x4* xr = (const f32x4*)src + lane;
    f32x4 v[4]; float s = 0.f;
#pragma unroll
    for (int j = 0; j < 4; ++j) { v[j] = xr[64 * j]; s += (v[j].x + v[j].y) + (v[j].z + v[j].w); }
    const float mean = wave_sum(s) * (1.f / DM); float s2 = 0.f;
#pragma unroll
    for (int j = 0; j < 4; ++j) { v[j] = v[j] - mean; s2 += (v[j].x * v[j].x + v[j].y * v[j].y) + (v[j].z * v[j].z + v[j].w * v[j].w); }
    const float rstd = 1.f / sqrtf(wave_sum(s2) * (1.f / DM) + LN_EPS);
#pragma unroll
    for (int j = 0; j < 4; ++j) { const f32x4 gg = ((const f32x4*)g)[lane + 64 * j], bb = ((const f32x4*)bta)[lane + 64 * j];
        const f32x4 o = v[j] * rstd * gg + bb;
        if (dstf) ((f32x4*)dstf)[lane + 64 * j] = o;
        u32x2 w; w.x = pk2(o.x, o.y); w.y = pk2(o.z, o.w); ((u32x2*)dstb)[lane + 64 * j] = w; }
}

__device__ __forceinline__ int crow(int r, int hi) { return (r & 3) + 8 * (r >> 2) + 4 * hi; }
__device__ __forceinline__ bf16x8 vfrag(const LAS unsigned char* p) {
    typedef short v4s __attribute__((ext_vector_type(4)));
    const v4s lo = __builtin_amdgcn_ds_read_tr16_b64_v4i16((LAS v4s*)p), hi = __builtin_amdgcn_ds_read_tr16_b64_v4i16((LAS v4s*)(p + 512));
    return (bf16x8){lo[0], lo[1], lo[2], lo[3], hi[0], hi[1], hi[2], hi[3]};
}
__device__ __forceinline__ void attn_unit(int b, int h, int qb, const bf16_t* QKV, bf16_t* AF, float lam, float oscale, const float* subg, LAS unsigned char* lds) {
    int tid_ = threadIdx.x; asm volatile("" : "+v"(tid_));
    const int tid = tid_, lane = tid & 63, r32 = lane & 31, hi = lane >> 5; const int wid = __builtin_amdgcn_readfirstlane(tid >> 6);
    const size_t rowbase = (size_t)b * SEQ; const int q0 = qb * 256 + wid * 32;
    const float slope2 = __builtin_amdgcn_exp2f(-(float)(h + 1)) * 1.4426950408889634f;
    bf16x8 qr[2][2];
    { const bf16_t* Qw = QKV + (rowbase + q0 + r32) * NQKV + h * 64;
#pragma unroll
      for (int c = 0; c < 2; ++c)
#pragma unroll
          for (int ks = 0; ks < 2; ++ks) qr[c][ks] = *(const bf16x8*)(Qw + c * 32 + ks * 16 + hi * 8); }
    const int skey = tid >> 3, sch = tid & 7;
    const bf16_t* kg = QKV + (rowbase + skey) * NQKV + 512 + h * 64 + sch * 8;
    const bf16_t* vg = kg + 512;
    const int kwo = skey * 128 + ((sch ^ ((skey >> 1) & 7)) << 4);
    const int vwo = 16384 + (sch >> 2) * 4096 + (skey >> 3) * 512 + (skey & 7) * 64 + (sch & 3) * 16;
    const int kx = hi ^ ((r32 >> 1) & 7);
    const int krb = r32 * 128;
    const int vrb = 16384 + ((lane >> 4) & 1) * 32 + (lane & 3) * 8 + (4 * hi + ((lane & 15) >> 2)) * 64;
    f32x16 o[2][2]; float mrow[2], lrow[2];
#pragma unroll
    for (int c = 0; c < 2; ++c) { mrow[c] = -1e30f; lrow[c] = 0.f;
#pragma unroll
        for (int d = 0; d < 2; ++d)
#pragma unroll
            for (int r = 0; r < 16; ++r) o[c][d][r] = 0.f; }
    const float kb0 = (float)(4 * hi) - (float)(q0 + r32);
    u32x4 kst = *(const u32x4*)kg, vst = *(const u32x4*)vg;
    for (int t = 0; t < SEQ / 64; ++t) {
        const int bo = (t & 1) * 8192;
        *(LAS u32x4*)(lds + bo + kwo) = kst; *(LAS u32x4*)(lds + bo + vwo) = vst;
        __syncthreads();
        if (t + 1 < SEQ / 64) { kst = *(const u32x4*)(kg + (size_t)(t + 1) * 64 * NQKV); vst = *(const u32x4*)(vg + (size_t)(t + 1) * 64 * NQKV); }
        const float tb = kb0 + (float)(t * 64);
#pragma unroll
        for (int c = 0; c < 2; ++c) {
            f32x16 s0, s1;
#pragma unroll
            for (int r = 0; r < 16; ++r) { s0[r] = 0.f; s1[r] = 0.f; }
#pragma unroll
            for (int ks = 0; ks < 2; ++ks) {
                const int off = bo + krb + ((((4 * c + 2 * ks) ^ kx)) << 4);
                const bf16x8 k0 = *(const LAS bf16x8*)(lds + off), k1 = *(const LAS bf16x8*)(lds + off + 4096);
                s0 = __builtin_amdgcn_mfma_f32_32x32x16_bf16(k0, qr[c][ks], s0, 0, 0, 0);
                s1 = __builtin_amdgcn_mfma_f32_32x32x16_bf16(k1, qr[c][ks], s1, 0, 0, 0);
            }
            float mx = -1e30f;
#pragma unroll
            for (int r = 0; r < 16; ++r) { const float dd = tb + (float)((r & 3) + 8 * (r >> 2));
                s0[r] = __builtin_fmaf(-slope2, __builtin_fabsf(dd), s0[r]); s1[r] = __builtin_fmaf(-slope2, __builtin_fabsf(dd + 32.f), s1[r]);
                mx = __builtin_fmaxf(mx, __builtin_fmaxf(s0[r], s1[r])); }
            mx = __builtin_fmaxf(mx, __shfl_xor(mx, 32));
            const float mnew = __builtin_fmaxf(mrow[c], mx), alpha = __builtin_amdgcn_exp2f(mrow[c] - mnew); mrow[c] = mnew;
            float rs = 0.f;
#pragma unroll
            for (int r = 0; r < 16; ++r) { s0[r] = __builtin_amdgcn_exp2f(s0[r] - mnew); s1[r] = __builtin_amdgcn_exp2f(s1[r] - mnew); rs += s0[r] + s1[r]; }
            lrow[c] = lrow[c] * alpha + rs;
#pragma unroll
            for (int d = 0; d < 2; ++d)
#pragma unroll
                for (int r = 0; r < 16; ++r) o[c][d][r] *= alpha;
            u32x4 pf[4];
            pf[0] = (u32x4){pg8::cvt_pk_bf16(s0[0], s0[1]), pg8::cvt_pk_bf16(s0[2], s0[3]), pg8::cvt_pk_bf16(s0[4], s0[5]), pg8::cvt_pk_bf16(s0[6], s0[7])};
            pf[1] = (u32x4){pg8::cvt_pk_bf16(s0[8], s0[9]), pg8::cvt_pk_bf16(s0[10], s0[11]), pg8::cvt_pk_bf16(s0[12], s0[13]), pg8::cvt_pk_bf16(s0[14], s0[15])};
            pf[2] = (u32x4){pg8::cvt_pk_bf16(s1[0], s1[1]), pg8::cvt_pk_bf16(s1[2], s1[3]), pg8::cvt_pk_bf16(s1[4], s1[5]), pg8::cvt_pk_bf16(s1[6], s1[7])};
            pf[3] = (u32x4){pg8::cvt_pk_bf16(s1[8], s1[9]), pg8::cvt_pk_bf16(s1[10], s1[11]), pg8::cvt_pk_bf16(s1[12], s1[13]), pg8::cvt_pk_bf16(s1[14], s1[15])};
#pragma unroll
            for (int d = 0; d < 2; ++d)
#pragma unroll
                for (int s4 = 0; s4 < 4; ++s4) {
                    const bf16x8 vf = vfrag(lds + bo + vrb + d * 4096 + s4 * 1024);
                    o[c][d] = __builtin_amdgcn_mfma_f32_32x32x16_bf16(vf, __builtin_bit_cast(bf16x8, pf[s4]), o[c][d], 0, 0, 0);
                }
        }
    }
    float inv[2];
#pragma unroll
    for (int c = 0; c < 2; ++c) { const float lt = lrow[c] + __shfl_xor(lrow[c], 32); inv[c] = 1.0f / lt; }
    const float w1 = lam * inv[1];
    float ss = 0.f;
#pragma unroll
    for (int d = 0; d < 2; ++d)
#pragma unroll
        for (int r = 0; r < 16; ++r) { const float v = o[0][d][r] * inv[0] - o[1][d][r] * w1; o[0][d][r] = v; ss += v * v; }
    ss += __shfl_xor(ss, 32);
    const float sc = oscale / sqrtf(ss * (1.0f / 64.0f) + SUBLN_EPS);
    bf16_t* orow = AF + (rowbase + q0 + r32) * 1024 + h * 64;
#pragma unroll
    for (int d = 0; d < 2; ++d)
#pragma unroll
        for (int g4 = 0; g4 < 4; ++g4) { const int dc = 32 * d + 8 * g4 + 4 * hi; const f32x4 gg = *(const f32x4*)(subg + dc);
            u32x2 w; w.x = pg8::cvt_pk_bf16(o[0][d][4 * g4] * sc * gg[0], o[0][d][4 * g4 + 1] * sc * gg[1]); w.y = pg8::cvt_pk_bf16(o[0][d][4 * g4 + 2] * sc * gg[2], o[0][d][4 * g4 + 3] * sc * gg[3]);
            *(u32x2*)(orow + dc) = w; }
    __syncthreads();
}

#ifndef PH_MASK
#define PH_MASK 0xFFFF
#endif
#define PH(k) if constexpr ((PH_MASK >> (k)) & 1)
#define GRID_SYNC() do { __threadfence(); grid.sync(); } while (0)
__global__ void __launch_bounds__(NTHREADS, 2) fwd_megakernel(Args args) {
    extern __shared__ __attribute__((aligned(16))) unsigned char lds_raw[];
    cg::grid_group grid = cg::this_grid();
    LAS unsigned char* lds = (LAS unsigned char*)lds_raw;
    const int G = gridDim.x, bx = blockIdx.x;
    const int vcu = (G % 8 == 0) ? (bx % 8) * (G / 8) + bx / 8 : bx;
    const int NGW = G * NWAVES;
#define LANE_VARS int tid_ = threadIdx.x; asm volatile("" : "+v"(tid_)); const int tid = tid_, lane = tid & 63, wave = __builtin_amdgcn_readfirstlane(tid >> 6), gw = vcu * NWAVES + wave; (void)tid; (void)lane; (void)gw;
    unsigned char* ws = args.ws;
    const float* x = args.in[0]; const float* ln_in_g = args.in[1]; const float* ln_in_b = args.in[2]; const float* w_in = args.in[3];
    const float* lam_params = args.in[4]; const float* subln_g = args.in[5]; const float* w_f = args.in[6]; const float* b_f = args.in[7];
    const float* w_o = args.in[8]; const float* ln1_g = args.in[9]; const float* ln1_b = args.in[10]; const float* w_gu = args.in[11];
    const float* w_down = args.in[12]; const float* ln2_g = args.in[13]; const float* ln2_b = args.in[14];
    bf16_t* XN = (bf16_t*)(ws + WS_XN); bf16_t* AF = XN; float* H = (float*)(ws + WS_H); float* PRE = args.out;
    bf16_t* QKV = (bf16_t*)(ws + WS_QKV); bf16_t* XT = (bf16_t*)(ws + WS_XT); bf16_t* ACT = (bf16_t*)(ws + WS_ACT); bf16_t* DMAT = (bf16_t*)(ws + WS_DMAT);

    PH(0) {
        LANE_VARS
        LAS float* scr = (LAS float*)(lds + wave * 8704);
        LAS float* tabc = (LAS float*)(lds + 8 * 8704); LAS float* tabs = tabc + 128;
        if (tid < 128) { const float a = (float)tid * (1.0f / 128.0f); tabc[tid] = __builtin_amdgcn_cosf(a) * 0.08838834764831845f; tabs[tid] = __builtin_amdgcn_sinf(a) * 0.08838834764831845f; }
        __syncthreads();
        constexpr int I_QKV = 16 * 48, I_O = 8 * 32, I_GU = 16 * 176, I_D = 44 * 32, I_L = I_QKV + I_O + I_GU + I_D;
        for (int it = gw; it < DEPTH * I_L; it += NGW) {
            const int l = it / I_L; int r = it % I_L; unsigned char* wl = ws + WS_W + (size_t)l * W_LAYER;
            if (r < I_QKV) { const int kb = r / 48, nb = r % 48; tr_item(w_in + (size_t)l * DM * 2048, 2048, (bf16_t*)(wl + W_QKV), DM, 64 * kb, 32 * nb, 0, nb < 16 ? QSCALE : 1.0f, scr, lane); continue; } r -= I_QKV;
            if (r < I_O) { const int kb = r / 32, nb = r % 32; tr_item(w_o + (size_t)l * DM * DM, DM, (bf16_t*)(wl + W_O), DM, 64 * kb, 32 * nb, 0, 1.0f, scr, lane); continue; } r -= I_O;
            if (r < I_GU) { const int kb = r / 176, nb = r % 176; tr_item(w_gu + (size_t)l * DM * NGU, NGU, (bf16_t*)(wl + W_GU), DM, 64 * kb, 32 * nb, 1, 1.0f, scr, lane); continue; } r -= I_GU;
            { const int kb = r / 32, nb = r % 32; tr_item(w_down + (size_t)l * FF * DM, DM, (bf16_t*)(wl + W_D), FF, 64 * kb, 32 * nb, 0, 1.0f, scr, lane); }
        }
        for (int it = gw; it < DEPTH * 1024; it += NGW) {
            const int l = it >> 10, r = it & 1023, g = r >> 8, kb = (r >> 4) & 15, cb = r & 15;
            const float* src = w_in + (size_t)l * DM * 2048 + (size_t)(64 * kb + lane) * 2048 + 1536 + 128 * g;
            float ac[8], as[8];
#pragma unroll
            for (int j = 0; j < 8; ++j) { ac[j] = 0.f; as[j] = 0.f; }
            for (int c4 = 0; c4 < 32; ++c4) { const f32x4 w = *(const f32x4*)(src + 4 * c4);
#pragma unroll
                for (int e = 0; e < 4; ++e) { const int c = 4 * c4 + e;
#pragma unroll
                    for (int j = 0; j < 8; ++j) { const int idx = (c * (8 * cb + j)) & 127; ac[j] += w[e] * tabc[idx]; as[j] += w[e] * tabs[idx]; } } }
            bf16_t* dst = (bf16_t*)(ws + WS_W + (size_t)l * W_LAYER + W_U);
#pragma unroll
            for (int j = 0; j < 8; ++j) { const int ch = 128 * g + 8 * cb + j;
                dst[(size_t)(2 * ch) * DM + 64 * kb + lane] = (bf16_t)f2bf(ac[j]); dst[(size_t)(2 * ch + 1) * DM + 64 * kb + lane] = (bf16_t)f2bf(as[j]); }
        }
        for (int it = gw; it < DEPTH * 1024; it += NGW) {
            const int l = it >> 10, r = it & 1023, g = r >> 8, nb = (r >> 4) & 15, cb = r & 15;
            const float* wo = w_o + (size_t)l * DM * DM + (size_t)(512 + 128 * g) * DM + 64 * nb + lane;
            const float* wf = w_f + (size_t)l * 4 * 128 * 128 + (size_t)g * 128 * 128 + (size_t)(8 * cb) * 128;
            float a8[8];
#pragma unroll
            for (int j = 0; j < 8; ++j) a8[j] = 0.f;
            for (int d = 0; d < 128; ++d) { const float w = wo[(size_t)d * DM];
#pragma unroll
                for (int j = 0; j < 8; ++j) a8[j] += wf[j * 128 + d] * w; }
            u32x4 o; o.x = pk2(a8[0], a8[1]); o.y = pk2(a8[2], a8[3]); o.z = pk2(a8[4], a8[5]); o.w = pk2(a8[6], a8[7]);
            *(u32x4*)((bf16_t*)(ws + WS_W + (size_t)l * W_LAYER + W_O) + (size_t)(64 * nb + lane) * DM + 512 + 128 * g + 8 * cb) = o;
        }
        for (int it = gw; it < DEPTH * 16; it += NGW) {
            const int l = it >> 4, nb = it & 15; const float* wo = w_o + (size_t)l * DM * DM + (size_t)512 * DM + 64 * nb + lane; const float* bf = b_f + l * 512;
            float a = 0.f; for (int j = 0; j < 512; ++j) a += bf[j] * wo[(size_t)j * DM];
            ((float*)(ws + WS_W + (size_t)l * W_LAYER + W_BO))[64 * nb + lane] = a;
        }
        for (int it = gw * 64 + lane; it < 4096 * 1024; it += NGW * 64) {
            const int s = it >> 10, c8 = (it & 1023) * 8, part = c8 >> 12, sp0 = c8 & 4095; float v[8];
#pragma unroll
            for (int j = 0; j < 8; ++j) { const float a = (float)((s * (sp0 + j)) & 4095) * (1.0f / 4096.0f); v[j] = (part ? -__builtin_amdgcn_sinf(a) : __builtin_amdgcn_cosf(a)) * 0.015625f; }
            u32x4 o; o.x = pk2(v[0], v[1]); o.y = pk2(v[2], v[3]); o.z = pk2(v[4], v[5]); o.w = pk2(v[6], v[7]);
            *(u32x4*)(DMAT + (size_t)s * 8192 + c8) = o;
        }
        for (int m = gw; m < MTOK; m += NGW) ln_row(x + (size_t)m * DM, ln_in_g, ln_in_b, H + (size_t)m * DM, XN + (size_t)m * DM, lane);
    }
    GRID_SYNC();

#pragma unroll 1
    for (int l = 0; l < DEPTH; ++l) {
        unsigned char* wl = ws + WS_W + (size_t)l * W_LAYER;
        const bf16_t* Wqkv_t = (const bf16_t*)(wl + W_QKV); const bf16_t* Wu_t = (const bf16_t*)(wl + W_U); const bf16_t* Wo_t = (const bf16_t*)(wl + W_O);
        const bf16_t* Wgu_t = (const bf16_t*)(wl + W_GU); const bf16_t* Wd_t = (const bf16_t*)(wl + W_D); const float* bias_o = (const float*)(wl + W_BO);
        PH(1) { pg8::Gemm g{XN, Wqkv_t, MTOK, NQKV, DM}; pg8::StaticOrder S; S.init(MTOK, NQKV, G, bx);
          pg8::EpiBf16 E{QKV, NQKV, 0, 0};
          pg8::gemm_phase<pg8::EpiBf16, pg8::StaticOrder, true, true>(lds, g, S, E); }
        PH(2) { pg8::Gemm g{Wu_t, XN, NU2, MTOK, DM}; pg8::StaticOrder S; S.init(NU2, MTOK, G, bx);
          pg8::EpiBf16 E{XT, SEQ, SEQ, (size_t)NU2 * SEQ};
          pg8::gemm_phase<pg8::EpiBf16, pg8::StaticOrder, true, true>(lds, g, S, E); }
        GRID_SYNC();
        PH(3) {
            const float* lp = lam_params + l * 128; float d01 = 0.f, d23 = 0.f;
            for (int i = 0; i < 32; ++i) { d01 += lp[i] * lp[32 + i]; d23 += lp[64 + i] * lp[96 + i]; }
            const float lam_init = 0.8f - 0.6f * expf(-0.3f * (float)l);
            const float lam = expf(d01) - expf(d23) + lam_init;
            for (int i = 0; i < 4; ++i) { const int u = i * G + vcu; if (u >= BATCH * NHEAD * 16) break;
                attn_unit(u >> 7, (u >> 4) & 7, u & 15, QKV, AF, lam, 1.0f - lam_init, subln_g + l * 64, lds); }
        }
        PH(4) { pg8::Gemm g{DMAT, XT, SEQ, BATCH * 512, 2 * SEQ}; pg8::StaticOrder S; S.init(SEQ, BATCH * 512, G, bx);
          pg8::EpiDft E{AF};
          pg8::gemm_phase<pg8::EpiDft, pg8::StaticOrder, true, true>(lds, g, S, E); }
        GRID_SYNC();
        PH(5) { pg8::Gemm g{AF, Wo_t, MTOK, DM, DM}; pg8::StaticOrder S; S.init(MTOK, DM, G, bx);
          pg8::EpiPre E{H, PRE, bias_o, ALPHA};
          pg8::gemm_phase<pg8::EpiPre, pg8::StaticOrder, true, true>(lds, g, S, E); }
        GRID_SYNC();
        PH(6) { LANE_VARS for (int m = gw; m < MTOK; m += NGW) ln_row(PRE + (size_t)m * DM, ln1_g + l * DM, ln1_b + l * DM, H + (size_t)m * DM, XN + (size_t)m * DM, lane); }
        GRID_SYNC();
        PH(7) { pg8::Gemm g{XN, Wgu_t, MTOK, NGU, DM}; pg8::StaticOrder S; S.init(MTOK, NGU, G, bx);
          pg8::EpiSwiGLU E{ACT, FF};
          pg8::gemm_phase<pg8::EpiSwiGLU, pg8::StaticOrder, true, true>(lds, g, S, E); }
        GRID_SYNC();
        PH(8) { pg8::Gemm g{ACT, Wd_t, MTOK, DM, FF}; pg8::StaticOrder S; S.init(MTOK, DM, G, bx);
          pg8::EpiPre E{H, PRE, nullptr, ALPHA};
          pg8::gemm_phase<pg8::EpiPre, pg8::StaticOrder, true, true>(lds, g, S, E); }
        GRID_SYNC();
        PH(9) { LANE_VARS const bool last = (l == DEPTH - 1);
          for (int m = gw; m < MTOK; m += NGW) ln_row(PRE + (size_t)m * DM, ln2_g + l * DM, ln2_b + l * DM, last ? PRE + (size_t)m * DM : H + (size_t)m * DM, XN + (size_t)m * DM, lane); }
        if (l + 1 < DEPTH) GRID_SYNC();
    }
}

constexpr int LDS_BYTES = 147456;
extern "C" void kernel_launch(void* const* d_in, const int* in_sizes, int n_in, void* d_out, int out_size, void* d_ws, size_t ws_size, hipStream_t stream) {
    static int grid = 0;
    if (grid == 0) {
        if (n_in != 15 || out_size != MTOK * DM || ws_size < WS_END) { fprintf(stderr, "kernel_launch: unexpected problem (n_in %d, out %d, ws %zu)\n", n_in, out_size, ws_size); grid = -1; return; }
        int dev = 0, cus = 0, per_cu = 0;
        hipGetDevice(&dev); hipDeviceGetAttribute(&cus, hipDeviceAttributeMultiprocessorCount, dev);
        hipFuncSetAttribute((const void*)fwd_megakernel, hipFuncAttributeMaxDynamicSharedMemorySize, LDS_BYTES);
        hipOccupancyMaxActiveBlocksPerMultiprocessor(&per_cu, (const void*)fwd_megakernel, NTHREADS, LDS_BYTES);
        if (per_cu < 1) { fprintf(stderr, "kernel_launch: occupancy query says %d blocks per CU\n", per_cu); grid = -1; return; }
        grid = cus;
        (void)hipGetLastError();
    }
    if (grid < 0) return;
    Args a{};
    for (int i = 0; i < 15; ++i) a.in[i] = (const float*)d_in[i];
    a.out = (float*)d_out; a.ws = (unsigned char*)d_ws;
    void* kargs[] = {&a};
    hipError_t e = hipLaunchCooperativeKernel((const void*)fwd_megakernel, dim3(grid), dim3(NTHREADS), kargs, LDS_BYTES, stream);
    if (e != hipSuccess) fprintf(stderr, "cooperative launch failed: %s (grid %d)\n", hipGetErrorString(e), grid);
}
```

```cpp
#include <hip/hip_runtime.h>
#include <hip/hip_cooperative_groups.h>
#include <cstdio>
#include <cstdint>
namespace cg = cooperative_groups;
namespace pg8 {
#define PG8_LAS __attribute__((address_space(3)))
typedef unsigned short bf16_t;
typedef short bf16x8 __attribute__((ext_vector_type(8)));
typedef float f32x4 __attribute__((ext_vector_type(4)));
typedef unsigned u32x4 __attribute__((ext_vector_type(4)));
constexpr int BM = 256, BK = 64, HALF = 128, HTB = HALF * BK * 2  , STAGE_BYTES = 8 * HTB, NXCD = 8, WGM = 8;

__host__ __device__ __forceinline__ int lds_byte(int r, int c) { const int st = (r >> 4) * 2 + (c >> 5), rr = r & 15, cc = c & 31, ob = rr * 64 + cc * 2; return st * 1024 + (ob ^ (((ob >> 9) & 1) << 5)); }
__host__ __device__ __forceinline__ void stage_rc(int b, int& R, int& C) { const int st = b / 1024, sb = b % 1024, swz = sb ^ (((sb >> 9) & 1) << 5); R = (st >> 1) * 16 + swz / 64; C = (st & 1) * 32 + (swz % 64) / 2; }
__host__ __device__ __forceinline__ int perm32(int rho) { const int n = rho >> 4, i = rho & 15; return 8 * (i >> 2) + 4 * n + (i & 3); }

struct Unit { int pm, pn; };
struct Gemm { const bf16_t* A; const bf16_t* Bt; int M, N, K; };

struct StaticOrder {
    int nM, nN, nwg, G, c;
    __host__ __device__ void init(int M, int N, int G_, int c_) { nM = M / BM; nN = N / BM; nwg = nM * nN; G = G_; c = c_; }
    __host__ __device__ bool next(int i, Unit& u) const {
        const long L = (long)i * G + c; if (L >= nwg) return false;
        int wgid = (int)L; { const int q = nwg / NXCD, r = nwg % NXCD, xcd = wgid % NXCD, off = wgid / NXCD; wgid = (xcd < r ? xcd * (q + 1) : r * (q + 1) + (xcd - r) * q) + off; }
        const int nig = WGM * nN, gid = wgid / nig, fm = gid * WGM, gsz = (nM - fm) < WGM ? (nM - fm) : WGM;
        u.pm = fm + ((wgid % nig) % gsz); u.pn = (wgid % nig) / gsz; return true;
    }
    __device__ __forceinline__ void a_ready(const Unit&) const {}
    __device__ __forceinline__ void done(const Unit&) const {}
};

__device__ __forceinline__ unsigned cvt_pk_bf16(float lo, float hi) { unsigned r; asm volatile("v_cvt_pk_bf16_f32 %0, %1, %2" : "=v"(r) : "v"(lo), "v"(hi)); return r; }
typedef float f32x2 __attribute__((ext_vector_type(2)));

struct EpiBf16 {
    static constexpr bool PERM = true, AFTER_DRAIN = false;
    bf16_t* O; int ldc; int split_cols; size_t split_stride;
    __device__ __forceinline__ void operator()(const f32x4 (&acc)[2][2][4][2], const Unit& u, int wr, int wc, int fr, int fq) const {
        const int row0 = u.pm * BM + wr * 64 + fr; int colt = u.pn * BM; bf16_t* base = O;
        if (split_cols) { const int t = colt / split_cols; base += (size_t)t * split_stride; colt -= t * split_cols; }
        const int col0 = colt + wc * 32 + 8 * fq;
#pragma unroll
        for (int ai = 0; ai < 2; ++ai)
#pragma unroll
            for (int m = 0; m < 4; ++m) { bf16_t* rowp = base + (size_t)(row0 + ai * HALF + m * 16) * ldc + col0;
#pragma unroll
                for (int bj = 0; bj < 2; ++bj) { const f32x4 v0 = acc[ai][bj][m][0], v1 = acc[ai][bj][m][1];
                    u32x4 w; w.x = cvt_pk_bf16(v0[0], v0[1]); w.y = cvt_pk_bf16(v0[2], v0[3]); w.z = cvt_pk_bf16(v1[0], v1[1]); w.w = cvt_pk_bf16(v1[2], v1[3]);
                    *(u32x4*)(rowp + bj * HALF) = w; } }
    }
};
struct EpiDft {
    static constexpr bool PERM = true, AFTER_DRAIN = false;
    bf16_t* O;
    __device__ __forceinline__ void operator()(const f32x4 (&acc)[2][2][4][2], const Unit& u, int wr, int wc, int fr, int fq) const {
        const int row0 = (u.pn >> 1) * 4096 + u.pm * BM + wr * 64 + fr; const int col0 = 512 + (u.pn & 1) * 256 + wc * 32 + 8 * fq;
#pragma unroll
        for (int ai = 0; ai < 2; ++ai)
#pragma unroll
            for (int m = 0; m < 4; ++m) { bf16_t* rowp = O + (size_t)(row0 + ai * HALF + m * 16) * 1024 + col0;
#pragma unroll
                for (int bj = 0; bj < 2; ++bj) { const f32x4 v0 = acc[ai][bj][m][0], v1 = acc[ai][bj][m][1];
                    u32x4 w; w.x = cvt_pk_bf16(v0[0], v0[1]); w.y = cvt_pk_bf16(v0[2], v0[3]); w.z = cvt_pk_bf16(v1[0], v1[1]); w.w = cvt_pk_bf16(v1[2], v1[3]);
                    *(u32x4*)(rowp + bj * HALF) = w; } }
    }
};
struct EpiSwiGLU {
    static constexpr bool PERM = true, AFTER_DRAIN = false;
    bf16_t* O; int ldc;
    __device__ __forceinline__ static float sw(float g, float up) { const float e = __builtin_amdgcn_exp2f(g * -1.4426950408889634f); return g * up * __builtin_amdgcn_rcpf(1.0f + e); }
    __device__ __forceinline__ void operator()(const f32x4 (&acc)[2][2][4][2], const Unit& u, int wr, int wc, int fr, int fq) const {
        const int row0 = u.pm * BM + wr * 64 + fr; const int col0 = u.pn * HALF + wc * 32 + 8 * fq;
#pragma unroll
        for (int ai = 0; ai < 2; ++ai)
#pragma unroll
            for (int m = 0; m < 4; ++m) { bf16_t* rowp = O + (size_t)(row0 + ai * HALF + m * 16) * ldc + col0;
                const f32x4 g0 = acc[ai][0][m][0], g1 = acc[ai][0][m][1], u0 = acc[ai][1][m][0], u1 = acc[ai][1][m][1];
                u32x4 w; w.x = cvt_pk_bf16(sw(g0[0], u0[0]), sw(g0[1], u0[1])); w.y = cvt_pk_bf16(sw(g0[2], u0[2]), sw(g0[3], u0[3]));
                w.z = cvt_pk_bf16(sw(g1[0], u1[0]), sw(g1[1], u1[1])); w.w = cvt_pk_bf16(sw(g1[2], u1[2]), sw(g1[3], u1[3]));
                *(u32x4*)rowp = w; }
    }
};
struct EpiPre {
    static constexpr bool PERM = false, AFTER_DRAIN = false;
    const float* H; float* PRE; const float* bias; float alpha;
    __device__ __forceinline__ void operator()(const f32x4 (&acc)[2][2][4][2], const Unit& u, int wr, int wc, int fr, int fq) const {
        const int col0 = u.pn * BM + wc * 32 + 4 * fq;
#pragma unroll
        for (int ai = 0; ai < 2; ++ai)
#pragma unroll
            for (int m = 0; m < 4; ++m) { const size_t off = (size_t)(u.pm * BM + ai * HALF + wr * 64 + m * 16 + fr) * 1024 + col0;
#pragma unroll
                for (int bj = 0; bj < 2; ++bj)
#pragma unroll
                    for (int n = 0; n < 2; ++n) { const int cc = bj * HALF + n * 16;
                        const f32x4 hb = *(const f32x4*)(H + off + cc); f32x4 o = hb * alpha + acc[ai][bj][m][n];
                        if (bias) o += *(const f32x4*)(bias + col0 + cc);
                        *(f32x4*)(PRE + off + cc) = o; } }
    }
};
template <class Epi, class Sched, bool ALIGN_EPI = false, bool SP2 = false>
__device__ __forceinline__ void gemm_phase(PG8_LAS unsigned char* lds, const Gemm g, const Sched& S, const Epi& E) {
    int tid_ = threadIdx.x; asm volatile("" : "+v"(tid_));
    const int tid = tid_, wid = __builtin_amdgcn_readfirstlane(tid >> 6), lane = tid & 63, wr = wid >> 2, wc = wid & 3, fr = lane & 15, fq = lane >> 4;
    const int K = g.K, nt = K / BK;
    unsigned voffA[2], voffB[2];
#pragma unroll
    for (int i = 0; i < 2; ++i) { int R, C; stage_rc(tid * 16 + i * 8192, R, C); const int Rb = Epi::PERM ? ((R & ~31) + perm32(R & 31)) : R;
        voffA[i] = (unsigned)(R * K + C) * 2u; voffB[i] = (unsigned)(Rb * K + C) * 2u; }
    const size_t kstep = (size_t)(BK * 2);
    const size_t hstep = (size_t)HALF * K * 2;
    const size_t tstep = 2 * hstep;
    const unsigned ldsw = (unsigned)wid * 1024u;
    const int aoff = lds_byte(wr * 64 + fr, fq * 8), boff = lds_byte(wc * 32 + fr, fq * 8);
#define PG8_SA(b, h) (((b) * 2 + (h)) * HTB)
#define PG8_SB(b, h) ((4 + (b) * 2 + (h)) * HTB)
#define PG8_STAGE(bufoff, gbase, voff) do { _Pragma("unroll") for (int _i = 0; _i < 2; ++_i) \
        __builtin_amdgcn_global_load_lds((const unsigned*)((const char*)(gbase) + (voff)[_i]), (PG8_LAS unsigned*)(lds + (bufoff) + ldsw + _i * 8192), 16, 0, 0); } while (0)
#define PG8_LDA(dst, b, h) do { _Pragma("unroll") for (int m = 0; m < 4; ++m) _Pragma("unroll") for (int k = 0; k < 2; ++k) dst[m][k] = *(const PG8_LAS bf16x8*)(lds + PG8_SA(b, h) + aoff + m * 2048 + k * 1024); } while (0)
#define PG8_LDB(dst, b, h) do { _Pragma("unroll") for (int n = 0; n < 2; ++n) _Pragma("unroll") for (int k = 0; k < 2; ++k) dst[n][k] = *(const PG8_LAS bf16x8*)(lds + PG8_SB(b, h) + boff + n * 2048 + k * 1024); } while (0)
#define PG8_MMA(ai, bj, At, Bt) do { __builtin_amdgcn_s_setprio(1); _Pragma("unroll") for (int m = 0; m < 4; ++m) _Pragma("unroll") for (int n = 0; n < 2; ++n) _Pragma("unroll") for (int k = 0; k < 2; ++k) \
        acc[ai][bj][m][n] = __builtin_amdgcn_mfma_f32_16x16x32_bf16(Bt[n][k], At[m][k], acc[ai][bj][m][n], 0, 0, 0); __builtin_amdgcn_s_setprio(0); } while (0)
#define PG8_WAIT_V(n) asm volatile("s_waitcnt vmcnt(" #n ")" ::: "memory")
#define PG8_WAIT_L(n) asm volatile("s_waitcnt lgkmcnt(" #n ")" ::: "memory")
#define PG8_BAR __builtin_amdgcn_s_barrier()
#define PG8_SCHED __builtin_amdgcn_sched_barrier(0)
    Unit cur, nxt; int ui = 0;
    if (!S.next(0, cur)) return;
    f32x4 acc[2][2][4][2];
#pragma unroll
    for (int a = 0; a < 2; ++a)
#pragma unroll
        for (int b = 0; b < 2; ++b)
#pragma unroll
            for (int m = 0; m < 4; ++m)
#pragma unroll
                for (int n = 0; n < 2; ++n) acc[a][b][m][n] = (f32x4){0.f, 0.f, 0.f, 0.f};
    bf16x8 At[4][2], B0[2][2], B1[2][2];
    const char* cA = (const char*)g.A + (size_t)cur.pm * tstep; const char* cB = (const char*)g.Bt + (size_t)cur.pn * tstep;
    S.a_ready(cur);
    if constexpr (SP2) {
        PG8_STAGE(PG8_SB(0, 0), cB, voffB); PG8_STAGE(PG8_SB(0, 1), cB + hstep, voffB); PG8_STAGE(PG8_SA(0, 0), cA, voffA); PG8_STAGE(PG8_SA(0, 1), cA + hstep, voffA);
        if (wr == 1) PG8_BAR;
        PG8_WAIT_V(2); PG8_BAR;
        PG8_STAGE(PG8_SB(1, 0), cB + kstep, voffB); PG8_STAGE(PG8_SA(1, 0), cA + kstep, voffA); PG8_STAGE(PG8_SB(1, 1), cB + hstep + kstep, voffB);
        PG8_WAIT_V(6); PG8_BAR;
    } else {
        PG8_STAGE(PG8_SB(0, 0), cB, voffB); PG8_STAGE(PG8_SA(0, 0), cA, voffA); PG8_STAGE(PG8_SB(0, 1), cB + hstep, voffB); PG8_STAGE(PG8_SA(0, 1), cA + hstep, voffA);
        if (wr == 1) PG8_BAR;
        PG8_WAIT_V(4); PG8_BAR;
        PG8_STAGE(PG8_SB(1, 0), cB + kstep, voffB); PG8_STAGE(PG8_SA(1, 0), cA + kstep, voffA); PG8_STAGE(PG8_SB(1, 1), cB + hstep + kstep, voffB);
        PG8_WAIT_V(6); PG8_BAR;
    }
    for (;;) {
        const bool has_next = S.next(ui + 1, nxt);
        const char* nA = has_next ? (const char*)g.A + (size_t)nxt.pm * tstep : cA; const char* nB = has_next ? (const char*)g.Bt + (size_t)nxt.pn * tstep : cB;
        for (int t = 0; t < nt; t += 2) {
            const bool last = (t == nt - 2);
            const char* a1 = cA + (size_t)(t + 1) * kstep;
            const char* a2 = last ? nA : cA + (size_t)(t + 2) * kstep; const char* b2 = last ? nB : cB + (size_t)(t + 2) * kstep;
            const char* a3 = a2 + kstep; const char* b3 = b2 + kstep;
            if (last && has_next) S.a_ready(nxt);
            if constexpr (SP2) {
            PG8_LDB(B0, 0, 0); PG8_LDB(B1, 0, 1); PG8_SCHED; PG8_LDA(At, 0, 0); PG8_STAGE(PG8_SA(1, 1), a1 + hstep, voffA);
            PG8_WAIT_V(8); PG8_WAIT_L(0); PG8_BAR; PG8_MMA(0, 0, At, B0); PG8_MMA(0, 1, At, B1); PG8_BAR; PG8_SCHED;
            PG8_LDA(At, 0, 1); PG8_STAGE(PG8_SB(0, 0), b2, voffB); PG8_STAGE(PG8_SB(0, 1), b2 + hstep, voffB); PG8_STAGE(PG8_SA(0, 0), a2, voffA);
            PG8_WAIT_V(8); PG8_WAIT_L(0); PG8_BAR; PG8_MMA(1, 0, At, B0); PG8_MMA(1, 1, At, B1); PG8_BAR; PG8_SCHED;
            PG8_LDB(B0, 1, 0); PG8_LDB(B1, 1, 1); PG8_SCHED; PG8_LDA(At, 1, 0); PG8_STAGE(PG8_SA(0, 1), a2 + hstep, voffA);
            PG8_WAIT_V(8); PG8_WAIT_L(0); PG8_BAR; PG8_MMA(0, 0, At, B0); PG8_MMA(0, 1, At, B1); PG8_BAR; PG8_SCHED;
            PG8_LDA(At, 1, 1); PG8_STAGE(PG8_SB(1, 0), b3, voffB); PG8_STAGE(PG8_SB(1, 1), b3 + hstep, voffB); PG8_STAGE(PG8_SA(1, 0), a3, voffA);
            PG8_WAIT_V(8); PG8_WAIT_L(0); PG8_BAR; PG8_MMA(1, 0, At, B0); PG8_MMA(1, 1, At, B1); PG8_BAR; PG8_SCHED;
            } else {
            PG8_LDB(B0, 0, 0); PG8_SCHED; PG8_LDA(At, 0, 0); PG8_STAGE(PG8_SA(1, 1), a1 + hstep, voffA);
            PG8_WAIT_L(8); PG8_BAR; PG8_WAIT_L(0); PG8_MMA(0, 0, At, B0); PG8_BAR; PG8_SCHED;
            PG8_LDB(B1, 0, 1); PG8_STAGE(PG8_SB(0, 0), b2, voffB);
            PG8_BAR; PG8_WAIT_L(0); PG8_MMA(0, 1, At, B1); PG8_BAR;
            PG8_LDA(At, 0, 1); PG8_STAGE(PG8_SA(0, 0), a2, voffA);
            PG8_BAR; PG8_WAIT_L(0); PG8_MMA(1, 0, At, B0); PG8_BAR; PG8_SCHED;
            PG8_STAGE(PG8_SB(0, 1), b2 + hstep, voffB);
            PG8_WAIT_V(6); PG8_BAR; PG8_MMA(1, 1, At, B1); PG8_BAR;
            PG8_LDB(B0, 1, 0); PG8_SCHED; PG8_LDA(At, 1, 0); PG8_STAGE(PG8_SA(0, 1), a2 + hstep, voffA);
            PG8_WAIT_L(8); PG8_BAR; PG8_WAIT_L(0); PG8_MMA(0, 0, At, B0); PG8_BAR; PG8_SCHED;
            PG8_LDB(B1, 1, 1); PG8_STAGE(PG8_SB(1, 0), b3, voffB);
            PG8_BAR; PG8_WAIT_L(0); PG8_MMA(0, 1, At, B1); PG8_BAR;
            PG8_LDA(At, 1, 1); PG8_STAGE(PG8_SA(1, 0), a3, voffA);
            PG8_BAR; PG8_WAIT_L(0); PG8_MMA(1, 0, At, B0); PG8_BAR; PG8_SCHED;
            PG8_STAGE(PG8_SB(1, 1), b3 + hstep, voffB);
            PG8_WAIT_V(6); PG8_BAR; PG8_MMA(1, 1, At, B1); PG8_BAR;
            }
        }
        if constexpr (ALIGN_EPI) { if (wr == 0) PG8_BAR; }
        if constexpr (!Epi::AFTER_DRAIN) { E(acc, cur, wr, wc, fr, fq); S.done(cur); }
        if (!has_next) break;
#pragma unroll
        for (int a = 0; a < 2; ++a)
#pragma unroll
            for (int b = 0; b < 2; ++b)
#pragma unroll
                for (int m = 0; m < 4; ++m)
#pragma unroll
                    for (int n = 0; n < 2; ++n) acc[a][b][m][n] = (f32x4){0.f, 0.f, 0.f, 0.f};
        cur = nxt; cA = nA; cB = nB; ++ui;
        if constexpr (ALIGN_EPI) { if (wr == 1) PG8_BAR; }
    }
    PG8_WAIT_V(0);
    if constexpr (!ALIGN_EPI) { if (wr == 0) PG8_BAR; }
    PG8_BAR;
    if constexpr (Epi::AFTER_DRAIN) { E.fused(acc, cur, wr, wc, fr, fq, lds, wid, lane); S.done(cur); }
#undef PG8_SA
#undef PG8_SB
#undef PG8_STAGE
#undef PG8_LDA
#undef PG8_LDB
#undef PG8_MMA
#undef PG8_WAIT_V
#undef PG8_WAIT_L
#undef PG8_BAR
#undef PG8_SCHED
}
}
constexpr int BATCH = 8, SEQ = 4096, DM = 1024, DEPTH = 2, MTOK = BATCH * SEQ;
constexpr int NQKV = 1536, NU2 = 1024, FF = 2816, NGU = 2 * FF, NHEAD = 8;
constexpr float LN_EPS = 1e-5f, SUBLN_EPS = 1e-5f;
constexpr float ALPHA = 1.4142135623730951f;
constexpr float QSCALE = 0.17677669529663687f * 1.4426950408889634f;
constexpr int NWAVES = 8, NTHREADS = 512;

typedef unsigned short bf16_t;
typedef short bf16x8 __attribute__((ext_vector_type(8)));
typedef short s16x4 __attribute__((ext_vector_type(4)));
typedef float f32x4 __attribute__((ext_vector_type(4)));
typedef float f32x16 __attribute__((ext_vector_type(16)));
typedef unsigned u32x4 __attribute__((ext_vector_type(4)));
typedef unsigned u32x2 __attribute__((ext_vector_type(2)));
#define LAS __attribute__((address_space(3)))

constexpr size_t MiB = 1u << 20;
constexpr size_t WS_CTL = 0;
constexpr size_t WS_W = 2 * MiB, W_LAYER = 24 * MiB;
constexpr size_t W_QKV = 0, W_U = 3 * MiB, W_O = 5 * MiB, W_GU = 7 * MiB, W_D = 18 * MiB, W_BO = 23 * MiB + 512 * 1024;
constexpr size_t WS_DMAT = 50 * MiB;
constexpr size_t WS_XN = 114 * MiB;
constexpr size_t WS_H = 178 * MiB;
constexpr size_t WS_QKV = 306 * MiB;
constexpr size_t WS_XT = 402 * MiB;
constexpr size_t WS_ACT = 306 * MiB;
constexpr size_t WS_END = 482 * MiB;

struct Args { const float* in[15]; float* out; unsigned char* ws; };

__device__ __forceinline__ unsigned f2bf(float f) { unsigned u = __builtin_bit_cast(unsigned, f); return (u + 0x7fffu + ((u >> 16) & 1u)) >> 16; }
__device__ __forceinline__ unsigned pk2(float lo, float hi) { return f2bf(lo) | (f2bf(hi) << 16); }
__device__ __forceinline__ float wave_sum(float v) {
#pragma unroll
    for (int o = 1; o < 64; o <<= 1) v += __shfl_xor(v, o);
    return v;
}

__device__ __forceinline__ void tr_item(const float* W, int ldw, bf16_t* WT, int ldt, int k0, int n0, int mode, float scale, LAS float* scr, int lane) {
#pragma unroll 8
    for (int i = 0; i < 32; ++i) { const int kk = 2 * i + (lane >> 5); scr[kk * 33 + (lane & 31)] = W[(size_t)(k0 + kk) * ldw + n0 + (lane & 31)] * scale; }
    asm volatile("s_waitcnt lgkmcnt(0)" ::: "memory");
    int r0 = n0;
    if (mode == 1) { const int part = n0 >= FF ? 1 : 0; const int ff = n0 - part * FF; r0 = (ff >> 7) * 256 + part * 128 + (ff & 127); }
    const int c = lane & 7;
#pragma unroll
    for (int j = 0; j < 4; ++j) { const int n = (lane >> 3) + 8 * j; const LAS float* s = scr + (8 * c) * 33 + n;
        u32x4 o; o.x = pk2(s[0 * 33], s[1 * 33]); o.y = pk2(s[2 * 33], s[3 * 33]); o.z = pk2(s[4 * 33], s[5 * 33]); o.w = pk2(s[6 * 33], s[7 * 33]);
        *(u32x4*)(WT + (size_t)(r0 + n) * ldt + k0 + 8 * c) = o; }
    asm volatile("s_waitcnt lgkmcnt(0)" ::: "memory");
}
__device__ __forceinline__ void ln_row(const float* src, const float* g, const float* bta, float* dstf, bf16_t* dstb, int lane) {
    const f32x4* xr = (const f32x4*)src + lane;
    f32x4 v[4]; float s = 0.f;
#pragma unroll
    for (int j = 0; j < 4; ++j) { v[j] = xr[64 * j]; s += (v[j].x + v[j].y) + (v[j].z + v[j].w); }
    const float mean = wave_sum(s) * (1.f / DM); float s2 = 0.f;
#pragma unroll
    for (int j = 0; j < 4; ++j) { v[j] = v[j] - mean; s2 += (v[j].x * v[j].x + v[j].y * v[j].y) + (v[j].z * v[j].z + v[j].w * v[j].w); }
    const float rstd = 1.f / sqrtf(wave_sum(s2) * (1.f / DM) + LN_EPS);
#pragma unroll
    for (int j = 0; j < 4; ++j) { const f32x4 gg = ((const f32x4*)g)[lane + 64 * j], bb = ((const f32x4*)bta)[lane + 64 * j];
        const f32x4 o = v[j] * rstd * gg + bb;
        if (dstf) ((f32x4*)dstf)[lane + 64 * j] = o;
        u32x2 w; w.x = pk2(o.x, o.y); w.y = pk2(o.z, o.w); ((u32x2*)dstb)[lane + 64 * j] = w; }
}

__device__ __forceinline__ int crow(int r, int hi) { return (r & 3) + 8 * (r >> 2) + 4 * hi; }
__device__ __forceinline__ bf16x8 vfrag(const LAS unsigned char* p) {
    typedef short v4s __attribute__((ext_vector_type(4)));
    const v4s lo = __builtin_amdgcn_ds_read_tr16_b64_v4i16((LAS v4s*)p), hi = __builtin_amdgcn_ds_read_tr16_b64_v4i16((LAS v4s*)(p + 512));
    return (bf16x8){lo[0], lo[1], lo[2], lo[3], hi[0], hi[1], hi[2], hi[3]};
}
__device__ __forceinline__ void attn_unit(int b, int h, int qb, const bf16_t* QKV, bf16_t* AF, float lam, float oscale, const float* subg, LAS unsigned char* lds) {
    int tid_ = threadIdx.x; asm volatile("" : "+v"(tid_));
    const int tid = tid_, lane = tid & 63, r32 = lane & 31, hi = lane >> 5; const int wid = __builtin_amdgcn_readfirstlane(tid >> 6);
    const size_t rowbase = (size_t)b * SEQ; const int q0 = qb * 256 + wid * 32;
    const float slope2 = __builtin_amdgcn_exp2f(-(float)(h + 1)) * 1.4426950408889634f;
    bf16x8 qr[2][2];
    { const bf16_t* Qw = QKV + (rowbase + q0 + r32) * NQKV + h * 64;
#pragma unroll
      for (int c = 0; c < 2; ++c)
#pragma unroll
          for (int ks = 0; ks < 2; ++ks) qr[c][ks] = *(const bf16x8*)(Qw + c * 32 + ks * 16 + hi * 8); }
    const int skey = tid >> 3, sch = tid & 7;
    const bf16_t* kg = QKV + (rowbase + skey) * NQKV + 512 + h * 64 + sch * 8;
    const bf16_t* vg = kg + 512;
    const int kwo = skey * 128 + ((sch ^ ((skey >> 1) & 7)) << 4);
    const int vwo = 16384 + (sch >> 2) * 4096 + (skey >> 3) * 512 + (skey & 7) * 64 + (sch & 3) * 16;
    const int kx = hi ^ ((r32 >> 1) & 7);
    const int krb = r32 * 128;
    const int vrb = 16384 + ((lane >> 4) & 1) * 32 + (lane & 3) * 8 + (4 * hi + ((lane & 15) >> 2)) * 64;
    f32x16 o[2][2]; float mrow[2], lrow[2];
#pragma unroll
    for (int c = 0; c < 2; ++c) { mrow[c] = -1e30f; lrow[c] = 0.f;
#pragma unroll
        for (int d = 0; d < 2; ++d)
#pragma unroll
            for (int r = 0; r < 16; ++r) o[c][d][r] = 0.f; }
    const float kb0 = (float)(4 * hi) - (float)(q0 + r32);
    u32x4 kst = *(const u32x4*)kg, vst = *(const u32x4*)vg;
    for (int t = 0; t < SEQ / 64; ++t) {
        const int bo = (t & 1) * 8192;
        *(LAS u32x4*)(lds + bo + kwo) = kst; *(LAS u32x4*)(lds + bo + vwo) = vst;
        __syncthreads();
        if (t + 1 < SEQ / 64) { kst = *(const u32x4*)(kg + (size_t)(t + 1) * 64 * NQKV); vst = *(const u32x4*)(vg + (size_t)(t + 1) * 64 * NQKV); }
        const float tb = kb0 + (float)(t * 64);
#pragma unroll
        for (int c = 0; c < 2; ++c) {
            f32x16 s0, s1;
#pragma unroll
            for (int r = 0; r < 16; ++r) { s0[r] = 0.f; s1[r] = 0.f; }
#pragma unroll
            for (int ks = 0; ks < 2; ++ks) {
                const int off = bo + krb + ((((4 * c + 2 * ks) ^ kx)) << 4);
                const bf16x8 k0 = *(const LAS bf16x8*)(lds + off), k1 = *(const LAS bf16x8*)(lds + off + 4096);
                s0 = __builtin_amdgcn_mfma_f32_32x32x16_bf16(k0, qr[c][ks], s0, 0, 0, 0);
                s1 = __builtin_amdgcn_mfma_f32_32x32x16_bf16(k1, qr[c][ks], s1, 0, 0, 0);
            }
            float mx = -1e30f;
#pragma unroll
            for (int r = 0; r < 16; ++r) { const float dd = tb + (float)((r & 3) + 8 * (r >> 2));
                s0[r] = __builtin_fmaf(-slope2, __builtin_fabsf(dd), s0[r]); s1[r] = __builtin_fmaf(-slope2, __builtin_fabsf(dd + 32.f), s1[r]);
                mx = __builtin_fmaxf(mx, __builtin_fmaxf(s0[r], s1[r])); }
            mx = __builtin_fmaxf(mx, __shfl_xor(mx, 32));
            const float mnew = __builtin_fmaxf(mrow[c], mx), alpha = __builtin_amdgcn_exp2f(mrow[c] - mnew); mrow[c] = mnew;
            float rs = 0.f;
#pragma unroll
            for (int r = 0; r < 16; ++r) { s0[r] = __builtin_amdgcn_exp2f(s0[r] - mnew); s1[r] = __builtin_amdgcn_exp2f(s1[r] - mnew); rs += s0[r] + s1[r]; }
            lrow[c] = lrow[c] * alpha + rs;
#pragma unroll
            for (int d = 0; d < 2; ++d)
#pragma unroll
                for (int r = 0; r < 16; ++r) o[c][d][r] *= alpha;
            u32x4 pf[4];
            pf[0] = (u32x4){pg8::cvt_pk_bf16(s0[0], s0[1]), pg8::cvt_pk_bf16(s0[2], s0[3]), pg8::cvt_pk_bf16(s0[4], s0[5]), pg8::cvt_pk_bf16(s0[6], s0[7])};
            pf[1] = (u32x4){pg8::cvt_pk_bf16(s0[8], s0[9]), pg8::cvt_pk_bf16(s0[10], s0[11]), pg8::cvt_pk_bf16(s0[12], s0[13]), pg8::cvt_pk_bf16(s0[14], s0[15])};
            pf[2] = (u32x4){pg8::cvt_pk_bf16(s1[0], s1[1]), pg8::cvt_pk_bf16(s1[2], s1[3]), pg8::cvt_pk_bf16(s1[4], s1[5]), pg8::cvt_pk_bf16(s1[6], s1[7])};
            pf[3] = (u32x4){pg8::cvt_pk_bf16(s1[8], s1[9]), pg8::cvt_pk_bf16(s1[10], s1[11]), pg8::cvt_pk_bf16(s1[12], s1[13]), pg8::cvt_pk_bf16(s1[14], s1[15])};
#pragma unroll
            for (int d = 0; d < 2; ++d)
#pragma unroll
                for (int s4 = 0; s4 < 4; ++s4) {
                    const bf16x8 vf = vfrag(lds + bo + vrb + d * 4096 + s4 * 1024);
                    o[c][d] = __builtin_amdgcn_mfma_f32_32x32x16_bf16(vf, __builtin_bit_cast(bf16x8, pf[s4]), o[c][d], 0, 0, 0);
                }
        }
    }
    float inv[2];
#pragma unroll
    for (int c = 0; c < 2; ++c) { const float lt = lrow[c] + __shfl_xor(lrow[c], 32); inv[c] = 1.0f / lt; }
    const float w1 = lam * inv[1];
    float ss = 0.f;
#pragma unroll
    for (int d = 0; d < 2; ++d)
#pragma unroll
        for (int r = 0; r < 16; ++r) { const float v = o[0][d][r] * inv[0] - o[1][d][r] * w1; o[0][d][r] = v; ss += v * v; }
    ss += __shfl_xor(ss, 32);
    const float sc = oscale / sqrtf(ss * (1.0f / 64.0f) + SUBLN_EPS);
    bf16_t* orow = AF + (rowbase + q0 + r32) * 1024 + h * 64;
#pragma unroll
    for (int d = 0; d < 2; ++d)
#pragma unroll
        for (int g4 = 0; g4 < 4; ++g4) { const int dc = 32 * d + 8 * g4 + 4 * hi; const f32x4 gg = *(const f32x4*)(subg + dc);
            u32x2 w; w.x = pg8::cvt_pk_bf16(o[0][d][4 * g4] * sc * gg[0], o[0][d][4 * g4 + 1] * sc * gg[1]); w.y = pg8::cvt_pk_bf16(o[0][d][4 * g4 + 2] * sc * gg[2], o[0][d][4 * g4 + 3] * sc * gg[3]);
            *(u32x2*)(orow + dc) = w; }
    __syncthreads();
}

#define RLX_AGENT __ATOMIC_RELAXED, __HIP_MEMORY_SCOPE_AGENT
constexpr int CW_BAR = 4096;
#define XB_TMO      128
#define XB_XCNT(j)  (256  + 64 * (j))
#define XB_XSUB(j)  (1280 + 64 * (j))
#define XB_XGEN(j)  (2304 + 64 * (j))
#define XB_TOP      3328
#define XB_TOPGEN   3392
#define XCD_BAR_WORDS 3456
#define XB_SPIN_CAP (1u << 18)

__device__ __forceinline__ unsigned xb_ld(unsigned* p)              { return __hip_atomic_load(p, __ATOMIC_RELAXED, __HIP_MEMORY_SCOPE_AGENT); }
__device__ __forceinline__ unsigned xb_add(unsigned* p, unsigned v) { return __hip_atomic_fetch_add(p, v, __ATOMIC_RELAXED, __HIP_MEMORY_SCOPE_AGENT); }
__device__ __forceinline__ unsigned xb_xcc_id() { return (unsigned)__builtin_amdgcn_s_getreg((3 << 11) | 20) & 0xFu; }
#define XB_SPIN(cond, bar) do { unsigned _sp = 0; while (cond) { __builtin_amdgcn_s_sleep(1); \
    if ((++_sp & 255u) == 0u) { if (xb_ld(&(bar)[XB_TMO])) break; if (_sp > XB_SPIN_CAP) { atomicAdd(&(bar)[XB_TMO], 1u); break; } } } } while (0)

struct XcdBarrier {
    unsigned* bar; unsigned x;
    volatile LAS unsigned* st;
};

__device__ __forceinline__ XcdBarrier xcd_barrier_post(unsigned* bar, volatile LAS unsigned* st) {
    XcdBarrier b; b.bar = bar; b.x = xb_xcc_id(); b.st = st;
    if (threadIdx.x == 0) (void)xb_add(&bar[XB_XCNT(b.x)], 1u);
    return b;
}
__device__ __forceinline__ void xcd_barrier_complete(unsigned* bar, unsigned x, unsigned& nloc, unsigned& nx) {
    const unsigned G = gridDim.x * gridDim.y * gridDim.z;
    unsigned sum, cnt, mine, sp = 0u;
    for (;;) {
        sum = 0u; cnt = 0u; mine = 0u;
#pragma unroll
        for (unsigned j = 0; j < 16; ++j) { const unsigned c = xb_ld(&bar[XB_XCNT(j)]); sum += c; cnt += (c > 0u) ? 1u : 0u; mine = (j == x) ? c : mine; }
        if (sum == G) break;
        __builtin_amdgcn_s_sleep(1);
        if ((++sp & 255u) == 0u) { if (xb_ld(&bar[XB_TMO])) break; if (sp > XB_SPIN_CAP) { atomicAdd(&bar[XB_TMO], 1u); break; } }
    }
    nloc = mine > 0u ? mine : 1u; nx = cnt > 0u ? cnt : 1u;
}

__device__ __forceinline__ void xcd_barrier(const XcdBarrier& b) {
    asm volatile("s_waitcnt vmcnt(0)" ::: "memory");
    __syncthreads();
    if (threadIdx.x == 0) {
        unsigned* bar = b.bar;
        __builtin_amdgcn_s_waitcnt(0);
        unsigned nloc = b.st[0], nx = b.st[1];
        if (nloc == 0u) { xcd_barrier_complete(bar, b.x, nloc, nx); b.st[0] = nloc; b.st[1] = nx; }
        const unsigned old = xb_add(&bar[XB_XSUB(b.x)], 1u);
        const unsigned gen = old / nloc;
        if (old + 1u == (gen + 1u) * nloc) {
            __builtin_amdgcn_fence(__ATOMIC_RELEASE, "agent");
            asm volatile("s_waitcnt vmcnt(0)" ::: "memory");
            const unsigned og = xb_add(&bar[XB_TOP], 1u);
            const unsigned tg = og / nx;
            if (og + 1u == (tg + 1u) * nx) xb_add(&bar[XB_TOPGEN], 1u);
            else XB_SPIN(xb_ld(&bar[XB_TOPGEN]) == tg, bar);
            __builtin_amdgcn_fence(__ATOMIC_ACQUIRE, "agent");
            xb_add(&bar[XB_XGEN(b.x)], 1u);
            asm volatile("s_waitcnt vmcnt(0)" ::: "memory");
        } else {
            XB_SPIN(xb_ld(&bar[XB_XGEN(b.x)]) == gen, bar);
            __builtin_amdgcn_fence(__ATOMIC_ACQUIRE, "agent");
            asm volatile("s_waitcnt vmcnt(0)" ::: "memory");
        }
    }
    __syncthreads();
}


#ifndef PH_MASK
#define PH_MASK 0xFFFF
#endif
#define PH(k) if constexpr ((PH_MASK >> (k)) & 1)
#ifndef REP_MASK
#define REP_MASK 0
#endif
#define REP(k) for (int rep_ = 0; rep_ < ((((REP_MASK) >> (k)) & 1) ? 2 : 1); ++rep_)
#define GRID_SYNC_CG() do { __threadfence(); grid.sync(); } while (0)
#define GRID_SYNC() xcd_barrier(bar)
__global__ void __launch_bounds__(NTHREADS, 2) fwd_megakernel(Args args) {
    extern __shared__ __attribute__((aligned(16))) unsigned char lds_raw[];
    cg::grid_group grid = cg::this_grid();
    LAS unsigned char* lds = (LAS unsigned char*)lds_raw;
    const int G = gridDim.x, bx = blockIdx.x;
    const int vcu = (G % 8 == 0) ? (bx % 8) * (G / 8) + bx / 8 : bx;
    const int NGW = G * NWAVES;
#define LANE_VARS int tid_ = threadIdx.x; asm volatile("" : "+v"(tid_)); const int tid = tid_, lane = tid & 63, wave = __builtin_amdgcn_readfirstlane(tid >> 6), gw = vcu * NWAVES + wave; (void)tid; (void)lane; (void)gw;
    unsigned char* ws = args.ws;
    volatile LAS unsigned* MISC = (volatile LAS unsigned*)(lds + 131072);
    if (threadIdx.x < 64) MISC[threadIdx.x] = 0u;
    __syncthreads();
    XcdBarrier bar = xcd_barrier_post((unsigned*)(ws + WS_CTL) + CW_BAR, MISC + 8);
    const float* x = args.in[0]; const float* ln_in_g = args.in[1]; const float* ln_in_b = args.in[2]; const float* w_in = args.in[3];
    const float* lam_params = args.in[4]; const float* subln_g = args.in[5]; const float* w_f = args.in[6]; const float* b_f = args.in[7];
    const float* w_o = args.in[8]; const float* ln1_g = args.in[9]; const float* ln1_b = args.in[10]; const float* w_gu = args.in[11];
    const float* w_down = args.in[12]; const float* ln2_g = args.in[13]; const float* ln2_b = args.in[14];
    bf16_t* XN = (bf16_t*)(ws + WS_XN); bf16_t* AF = XN; float* H = (float*)(ws + WS_H); float* PRE = args.out;
    bf16_t* QKV = (bf16_t*)(ws + WS_QKV); bf16_t* XT = (bf16_t*)(ws + WS_XT); bf16_t* ACT = (bf16_t*)(ws + WS_ACT); bf16_t* DMAT = (bf16_t*)(ws + WS_DMAT);

    PH(0) REP(0) {
        LANE_VARS
        LAS float* scr = (LAS float*)(lds + wave * 8704);
        LAS float* tabc = (LAS float*)(lds + 8 * 8704); LAS float* tabs = tabc + 128;
        if (tid < 128) { const float a = (float)tid * (1.0f / 128.0f); tabc[tid] = __builtin_amdgcn_cosf(a) * 0.08838834764831845f; tabs[tid] = __builtin_amdgcn_sinf(a) * 0.08838834764831845f; }
        __syncthreads();
        constexpr int I_QKV = 16 * 48, I_O = 8 * 32, I_GU = 16 * 176, I_D = 44 * 32, I_L = I_QKV + I_O + I_GU + I_D;
        for (int it = gw; it < DEPTH * I_L; it += NGW) {
            const int l = it / I_L; int r = it % I_L; unsigned char* wl = ws + WS_W + (size_t)l * W_LAYER;
            if (r < I_QKV) { const int kb = r / 48, nb = r % 48; tr_item(w_in + (size_t)l * DM * 2048, 2048, (bf16_t*)(wl + W_QKV), DM, 64 * kb, 32 * nb, 0, nb < 16 ? QSCALE : 1.0f, scr, lane); continue; } r -= I_QKV;
            if (r < I_O) { const int kb = r / 32, nb = r % 32; tr_item(w_o + (size_t)l * DM * DM, DM, (bf16_t*)(wl + W_O), DM, 64 * kb, 32 * nb, 0, 1.0f, scr, lane); continue; } r -= I_O;
            if (r < I_GU) { const int kb = r / 176, nb = r % 176; tr_item(w_gu + (size_t)l * DM * NGU, NGU, (bf16_t*)(wl + W_GU), DM, 64 * kb, 32 * nb, 1, 1.0f, scr, lane); continue; } r -= I_GU;
            { const int kb = r / 32, nb = r % 32; tr_item(w_down + (size_t)l * FF * DM, DM, (bf16_t*)(wl + W_D), FF, 64 * kb, 32 * nb, 0, 1.0f, scr, lane); }
        }
        for (int it = gw; it < DEPTH * 1024; it += NGW) {
            const int l = it >> 10, r = it & 1023, g = r >> 8, kb = (r >> 4) & 15, cb = r & 15;
            const float* src = w_in + (size_t)l * DM * 2048 + (size_t)(64 * kb + lane) * 2048 + 1536 + 128 * g;
            float ac[8], as[8];
#pragma unroll
            for (int j = 0; j < 8; ++j) { ac[j] = 0.f; as[j] = 0.f; }
            for (int c4 = 0; c4 < 32; ++c4) { const f32x4 w = *(const f32x4*)(src + 4 * c4);
#pragma unroll
                for (int e = 0; e < 4; ++e) { const int c = 4 * c4 + e;
#pragma unroll
                    for (int j = 0; j < 8; ++j) { const int idx = (c * (8 * cb + j)) & 127; ac[j] += w[e] * tabc[idx]; as[j] += w[e] * tabs[idx]; } } }
            bf16_t* dst = (bf16_t*)(ws + WS_W + (size_t)l * W_LAYER + W_U);
#pragma unroll
            for (int j = 0; j < 8; ++j) { const int ch = 128 * g + 8 * cb + j;
                dst[(size_t)(2 * ch) * DM + 64 * kb + lane] = (bf16_t)f2bf(ac[j]); dst[(size_t)(2 * ch + 1) * DM + 64 * kb + lane] = (bf16_t)f2bf(as[j]); }
        }
        for (int it = gw; it < DEPTH * 1024; it += NGW) {
            const int l = it >> 10, r = it & 1023, g = r >> 8, nb = (r >> 4) & 15, cb = r & 15;
            const float* wo = w_o + (size_t)l * DM * DM + (size_t)(512 + 128 * g) * DM + 64 * nb + lane;
            const float* wf = w_f + (size_t)l * 4 * 128 * 128 + (size_t)g * 128 * 128 + (size_t)(8 * cb) * 128;
            float a8[8];
#pragma unroll
            for (int j = 0; j < 8; ++j) a8[j] = 0.f;
            for (int d = 0; d < 128; ++d) { const float w = wo[(size_t)d * DM];
#pragma unroll
                for (int j = 0; j < 8; ++j) a8[j] += wf[j * 128 + d] * w; }
            u32x4 o; o.x = pk2(a8[0], a8[1]); o.y = pk2(a8[2], a8[3]); o.z = pk2(a8[4], a8[5]); o.w = pk2(a8[6], a8[7]);
            *(u32x4*)((bf16_t*)(ws + WS_W + (size_t)l * W_LAYER + W_O) + (size_t)(64 * nb + lane) * DM + 512 + 128 * g + 8 * cb) = o;
        }
        for (int it = gw; it < DEPTH * 16; it += NGW) {
            const int l = it >> 4, nb = it & 15; const float* wo = w_o + (size_t)l * DM * DM + (size_t)512 * DM + 64 * nb + lane; const float* bf = b_f + l * 512;
            float a = 0.f; for (int j = 0; j < 512; ++j) a += bf[j] * wo[(size_t)j * DM];
            ((float*)(ws + WS_W + (size_t)l * W_LAYER + W_BO))[64 * nb + lane] = a;
        }
        for (int it = gw * 64 + lane; it < 4096 * 1024; it += NGW * 64) {
            const int s = it >> 10, c8 = (it & 1023) * 8, part = c8 >> 12, sp0 = c8 & 4095; float v[8];
#pragma unroll
            for (int j = 0; j < 8; ++j) { const float a = (float)((s * (sp0 + j)) & 4095) * (1.0f / 4096.0f); v[j] = (part ? -__builtin_amdgcn_sinf(a) : __builtin_amdgcn_cosf(a)) * 0.015625f; }
            u32x4 o; o.x = pk2(v[0], v[1]); o.y = pk2(v[2], v[3]); o.z = pk2(v[4], v[5]); o.w = pk2(v[6], v[7]);
            *(u32x4*)(DMAT + (size_t)s * 8192 + c8) = o;
        }
        for (int m = gw; m < MTOK; m += NGW) ln_row(x + (size_t)m * DM, ln_in_g, ln_in_b, H + (size_t)m * DM, XN + (size_t)m * DM, lane);
    }
    GRID_SYNC_CG();

#pragma unroll 1
    for (int l = 0; l < DEPTH; ++l) {
        unsigned char* wl = ws + WS_W + (size_t)l * W_LAYER;
        const bf16_t* Wqkv_t = (const bf16_t*)(wl + W_QKV); const bf16_t* Wu_t = (const bf16_t*)(wl + W_U); const bf16_t* Wo_t = (const bf16_t*)(wl + W_O);
        const bf16_t* Wgu_t = (const bf16_t*)(wl + W_GU); const bf16_t* Wd_t = (const bf16_t*)(wl + W_D); const float* bias_o = (const float*)(wl + W_BO);
        PH(1) REP(1) { pg8::Gemm g{XN, Wqkv_t, MTOK, NQKV, DM}; pg8::StaticOrder S; S.init(MTOK, NQKV, G, bx);
          pg8::EpiBf16 E{QKV, NQKV, 0, 0};
          pg8::gemm_phase<pg8::EpiBf16, pg8::StaticOrder, true, true>(lds, g, S, E); }
        PH(2) REP(2) { pg8::Gemm g{Wu_t, XN, NU2, MTOK, DM}; pg8::StaticOrder S; S.init(NU2, MTOK, G, bx);
          pg8::EpiBf16 E{XT, SEQ, SEQ, (size_t)NU2 * SEQ};
          pg8::gemm_phase<pg8::EpiBf16, pg8::StaticOrder, true, true>(lds, g, S, E); }
        GRID_SYNC();
        PH(3) REP(3) {
            const float* lp = lam_params + l * 128; float d01 = 0.f, d23 = 0.f;
            for (int i = 0; i < 32; ++i) { d01 += lp[i] * lp[32 + i]; d23 += lp[64 + i] * lp[96 + i]; }
            const float lam_init = 0.8f - 0.6f * expf(-0.3f * (float)l);
            const float lam = expf(d01) - expf(d23) + lam_init;
            for (int i = 0; i < 4; ++i) { const int u = i * G + vcu; if (u >= BATCH * NHEAD * 16) break;
                attn_unit(u >> 7, (u >> 4) & 7, u & 15, QKV, AF, lam, 1.0f - lam_init, subln_g + l * 64, lds); }
        }
        PH(4) REP(4) { pg8::Gemm g{DMAT, XT, SEQ, BATCH * 512, 2 * SEQ}; pg8::StaticOrder S; S.init(SEQ, BATCH * 512, G, bx);
          pg8::EpiDft E{AF};
          pg8::gemm_phase<pg8::EpiDft, pg8::StaticOrder, true, true>(lds, g, S, E); }
        GRID_SYNC();
        PH(5) REP(5) { pg8::Gemm g{AF, Wo_t, MTOK, DM, DM}; pg8::StaticOrder S; S.init(MTOK, DM, G, bx);
          pg8::EpiPre E{H, PRE, bias_o, ALPHA};
          pg8::gemm_phase<pg8::EpiPre, pg8::StaticOrder, true, true>(lds, g, S, E); }
        GRID_SYNC();
        PH(6) REP(6) { LANE_VARS for (int m = gw; m < MTOK; m += NGW) ln_row(PRE + (size_t)m * DM, ln1_g + l * DM, ln1_b + l * DM, H + (size_t)m * DM, XN + (size_t)m * DM, lane); }
        GRID_SYNC();
        PH(7) REP(7) { pg8::Gemm g{XN, Wgu_t, MTOK, NGU, DM}; pg8::StaticOrder S; S.init(MTOK, NGU, G, bx);
          pg8::EpiSwiGLU E{ACT, FF};
          pg8::gemm_phase<pg8::EpiSwiGLU, pg8::StaticOrder, true, true>(lds, g, S, E); }
        GRID_SYNC();
        PH(8) REP(8) { pg8::Gemm g{ACT, Wd_t, MTOK, DM, FF}; pg8::StaticOrder S; S.init(MTOK, DM, G, bx);
          pg8::EpiPre E{H, PRE, nullptr, ALPHA};
          pg8::gemm_phase<pg8::EpiPre, pg8::StaticOrder, true, true>(lds, g, S, E); }
        GRID_SYNC();
        PH(9) { LANE_VARS const bool last = (l == DEPTH - 1);
          for (int m = gw; m < MTOK; m += NGW) ln_row(PRE + (size_t)m * DM, ln2_g + l * DM, ln2_b + l * DM, last ? PRE + (size_t)m * DM : H + (size_t)m * DM, XN + (size_t)m * DM, lane); }
        if (l + 1 < DEPTH) GRID_SYNC();
    }
}

constexpr int LDS_BYTES = 147456;
extern "C" void kernel_launch(void* const* d_in, const int* in_sizes, int n_in, void* d_out, int out_size, void* d_ws, size_t ws_size, hipStream_t stream) {
    static int grid = 0;
    if (grid == 0) {
        if (n_in != 15 || out_size != MTOK * DM || ws_size < WS_END) { fprintf(stderr, "kernel_launch: unexpected problem (n_in %d, out %d, ws %zu)\n", n_in, out_size, ws_size); grid = -1; return; }
        int dev = 0, cus = 0, per_cu = 0;
        hipGetDevice(&dev); hipDeviceGetAttribute(&cus, hipDeviceAttributeMultiprocessorCount, dev);
        hipFuncSetAttribute((const void*)fwd_megakernel, hipFuncAttributeMaxDynamicSharedMemorySize, LDS_BYTES);
        hipOccupancyMaxActiveBlocksPerMultiprocessor(&per_cu, (const void*)fwd_megakernel, NTHREADS, LDS_BYTES);
        if (per_cu < 1) { fprintf(stderr, "kernel_launch: occupancy query says %d blocks per CU\n", per_cu); grid = -1; return; }
        grid = cus;
        (void)hipGetLastError();
    }
    if (grid < 0) return;
    if (hipMemsetAsync((char*)d_ws + WS_CTL, 0, 65536, stream) != hipSuccess) { fprintf(stderr, "kernel_launch: memset failed\n"); return; }
    Args a{};
    for (int i = 0; i < 15; ++i) a.in[i] = (const float*)d_in[i];
    a.out = (float*)d_out; a.ws = (unsigned char*)d_ws;
    void* kargs[] = {&a};
    hipError_t e = hipLaunchCooperativeKernel((const void*)fwd_megakernel, dim3(grid), dim3(NTHREADS), kargs, LDS_BYTES, stream);
    if (e != hipSuccess) fprintf(stderr, "cooperative launch failed: %s (grid %d)\n", hipGetErrorString(e), grid);
}
```

```cpp
#include <hip/hip_runtime.h>
#include <hip/hip_cooperative_groups.h>
#include <cstdio>
#include <cstdint>
namespace cg = cooperative_groups;
namespace pg8 {
#define PG8_LAS __attribute__((address_space(3)))
typedef unsigned short bf16_t;
typedef short bf16x8 __attribute__((ext_vector_type(8)));
typedef float f32x4 __attribute__((ext_vector_type(4)));
typedef unsigned u32x4 __attribute__((ext_vector_type(4)));
constexpr int BM = 256, BK = 64, HALF = 128, HTB = HALF * BK * 2  , STAGE_BYTES = 8 * HTB, NXCD = 8, WGM = 8;

__host__ __device__ __forceinline__ int lds_byte(int r, int c) { const int st = (r >> 4) * 2 + (c >> 5), rr = r & 15, cc = c & 31, ob = rr * 64 + cc * 2; return st * 1024 + (ob ^ (((ob >> 9) & 1) << 5)); }
__host__ __device__ __forceinline__ void stage_rc(int b, int& R, int& C) { const int st = b / 1024, sb = b % 1024, swz = sb ^ (((sb >> 9) & 1) << 5); R = (st >> 1) * 16 + swz / 64; C = (st & 1) * 32 + (swz % 64) / 2; }
__host__ __device__ __forceinline__ int perm32(int rho) { const int n = rho >> 4, i = rho & 15; return 8 * (i >> 2) + 4 * n + (i & 3); }

struct Unit { int pm, pn; };
struct Gemm { const bf16_t* A; const bf16_t* Bt; int M, N, K; };

struct StaticOrder {
    int nM, nN, nwg, G, c;
    __host__ __device__ void init(int M, int N, int G_, int c_) { nM = M / BM; nN = N / BM; nwg = nM * nN; G = G_; c = c_; }
    __host__ __device__ bool next(int i, Unit& u) const {
        const long L = (long)i * G + c; if (L >= nwg) return false;
        int wgid = (int)L; { const int q = nwg / NXCD, r = nwg % NXCD, xcd = wgid % NXCD, off = wgid / NXCD; wgid = (xcd < r ? xcd * (q + 1) : r * (q + 1) + (xcd - r) * q) + off; }
        const int nig = WGM * nN, gid = wgid / nig, fm = gid * WGM, gsz = (nM - fm) < WGM ? (nM - fm) : WGM;
        u.pm = fm + ((wgid % nig) % gsz); u.pn = (wgid % nig) / gsz; return true;
    }
    __device__ __forceinline__ void a_ready(const Unit&) const {}
    __device__ __forceinline__ void done(const Unit&) const {}
};

__device__ __forceinline__ unsigned cvt_pk_bf16(float lo, float hi) { unsigned r; asm volatile("v_cvt_pk_bf16_f32 %0, %1, %2" : "=v"(r) : "v"(lo), "v"(hi)); return r; }
typedef float f32x2 __attribute__((ext_vector_type(2)));

struct EpiBf16 {
    static constexpr bool PERM = true, AFTER_DRAIN = false;
    bf16_t* O; int ldc; int split_cols; size_t split_stride;
    __device__ __forceinline__ void operator()(const f32x4 (&acc)[2][2][4][2], const Unit& u, int wr, int wc, int fr, int fq) const {
        const int row0 = u.pm * BM + wr * 64 + fr; int colt = u.pn * BM; bf16_t* base = O;
        if (split_cols) { const int t = colt / split_cols; base += (size_t)t * split_stride; colt -= t * split_cols; }
        const int col0 = colt + wc * 32 + 8 * fq;
#pragma unroll
        for (int ai = 0; ai < 2; ++ai)
#pragma unroll
            for (int m = 0; m < 4; ++m) { bf16_t* rowp = base + (size_t)(row0 + ai * HALF + m * 16) * ldc + col0;
#pragma unroll
                for (int bj = 0; bj < 2; ++bj) { const f32x4 v0 = acc[ai][bj][m][0], v1 = acc[ai][bj][m][1];
                    u32x4 w; w.x = cvt_pk_bf16(v0[0], v0[1]); w.y = cvt_pk_bf16(v0[2], v0[3]); w.z = cvt_pk_bf16(v1[0], v1[1]); w.w = cvt_pk_bf16(v1[2], v1[3]);
                    *(u32x4*)(rowp + bj * HALF) = w; } }
    }
};
struct EpiQKV {
    static constexpr bool PERM = true, AFTER_DRAIN = false;
    bf16_t* O; unsigned* kmax;
    __device__ __forceinline__ void operator()(const f32x4 (&acc)[2][2][4][2], const Unit& u, int wr, int wc, int fr, int fq) const {
        const int row0 = u.pm * BM + wr * 64 + fr; const int col0 = u.pn * BM + wc * 32 + 8 * fq;
        const bool isk = (u.pn == 2 || u.pn == 3);
        float kn[2] = {0.f, 0.f};
#pragma unroll
        for (int ai = 0; ai < 2; ++ai)
#pragma unroll
            for (int m = 0; m < 4; ++m) { bf16_t* rowp = O + (size_t)(row0 + ai * HALF + m * 16) * 1536 + col0;
#pragma unroll
                for (int bj = 0; bj < 2; ++bj) { const f32x4 v0 = acc[ai][bj][m][0], v1 = acc[ai][bj][m][1];
                    u32x4 w; w.x = cvt_pk_bf16(v0[0], v0[1]); w.y = cvt_pk_bf16(v0[2], v0[3]); w.z = cvt_pk_bf16(v1[0], v1[1]); w.w = cvt_pk_bf16(v1[2], v1[3]);
                    *(u32x4*)(rowp + bj * HALF) = w;
                    if (isk) { float ss = (v0[0] * v0[0] + v0[1] * v0[1]) + (v0[2] * v0[2] + v0[3] * v0[3]) + (v1[0] * v1[0] + v1[1] * v1[1]) + (v1[2] * v1[2] + v1[3] * v1[3]);
                        ss += __shfl_xor(ss, 16); ss += __shfl_xor(ss, 32); kn[bj] = __builtin_fmaxf(kn[bj], ss); } } }
        if (isk) {
#pragma unroll
            for (int bj = 0; bj < 2; ++bj) { float v = kn[bj];
                v = __builtin_fmaxf(v, __shfl_xor(v, 1)); v = __builtin_fmaxf(v, __shfl_xor(v, 2)); v = __builtin_fmaxf(v, __shfl_xor(v, 4)); v = __builtin_fmaxf(v, __shfl_xor(v, 8));
                if (fr == 0 && fq == 0) atomicMax(kmax + (u.pm >> 4) * 8 + 4 * (u.pn - 2) + 2 * bj + (wc >> 1), __builtin_bit_cast(unsigned, v)); }
        }
    }
};
struct EpiDft {
    static constexpr bool PERM = true, AFTER_DRAIN = false;
    bf16_t* O;
    __device__ __forceinline__ void operator()(const f32x4 (&acc)[2][2][4][2], const Unit& u, int wr, int wc, int fr, int fq) const {
        const int row0 = (u.pn >> 1) * 4096 + u.pm * BM + wr * 64 + fr; const int col0 = 512 + (u.pn & 1) * 256 + wc * 32 + 8 * fq;
#pragma unroll
        for (int ai = 0; ai < 2; ++ai)
#pragma unroll
            for (int m = 0; m < 4; ++m) { bf16_t* rowp = O + (size_t)(row0 + ai * HALF + m * 16) * 1024 + col0;
#pragma unroll
                for (int bj = 0; bj < 2; ++bj) { const f32x4 v0 = acc[ai][bj][m][0], v1 = acc[ai][bj][m][1];
                    u32x4 w; w.x = cvt_pk_bf16(v0[0], v0[1]); w.y = cvt_pk_bf16(v0[2], v0[3]); w.z = cvt_pk_bf16(v1[0], v1[1]); w.w = cvt_pk_bf16(v1[2], v1[3]);
                    *(u32x4*)(rowp + bj * HALF) = w; } }
    }
};
struct EpiSwiGLU {
    static constexpr bool PERM = true, AFTER_DRAIN = false;
    bf16_t* O; int ldc;
    __device__ __forceinline__ static float sw(float g, float up) { const float e = __builtin_amdgcn_exp2f(g * -1.4426950408889634f); return g * up * __builtin_amdgcn_rcpf(1.0f + e); }
    __device__ __forceinline__ void operator()(const f32x4 (&acc)[2][2][4][2], const Unit& u, int wr, int wc, int fr, int fq) const {
        const int row0 = u.pm * BM + wr * 64 + fr; const int col0 = u.pn * HALF + wc * 32 + 8 * fq;
#pragma unroll
        for (int ai = 0; ai < 2; ++ai)
#pragma unroll
            for (int m = 0; m < 4; ++m) { bf16_t* rowp = O + (size_t)(row0 + ai * HALF + m * 16) * ldc + col0;
                const f32x4 g0 = acc[ai][0][m][0], g1 = acc[ai][0][m][1], u0 = acc[ai][1][m][0], u1 = acc[ai][1][m][1];
                u32x4 w; w.x = cvt_pk_bf16(sw(g0[0], u0[0]), sw(g0[1], u0[1])); w.y = cvt_pk_bf16(sw(g0[2], u0[2]), sw(g0[3], u0[3]));
                w.z = cvt_pk_bf16(sw(g1[0], u1[0]), sw(g1[1], u1[1])); w.w = cvt_pk_bf16(sw(g1[2], u1[2]), sw(g1[3], u1[3]));
                *(u32x4*)rowp = w; }
    }
};
struct EpiPre {
    static constexpr bool PERM = false, AFTER_DRAIN = false;
    const float* H; float* PRE; const float* bias; float alpha;
    __device__ __forceinline__ void operator()(const f32x4 (&acc)[2][2][4][2], const Unit& u, int wr, int wc, int fr, int fq) const {
        const int col0 = u.pn * BM + wc * 32 + 4 * fq;
#pragma unroll
        for (int ai = 0; ai < 2; ++ai)
#pragma unroll
            for (int m = 0; m < 4; ++m) { const size_t off = (size_t)(u.pm * BM + ai * HALF + wr * 64 + m * 16 + fr) * 1024 + col0;
#pragma unroll
                for (int bj = 0; bj < 2; ++bj)
#pragma unroll
                    for (int n = 0; n < 2; ++n) { const int cc = bj * HALF + n * 16;
                        const f32x4 hb = *(const f32x4*)(H + off + cc); f32x4 o = hb * alpha + acc[ai][bj][m][n];
                        if (bias) o += *(const f32x4*)(bias + col0 + cc);
                        *(f32x4*)(PRE + off + cc) = o; } }
    }
};
template <class Epi, class Sched, bool ALIGN_EPI = false, bool SP2 = false>
__device__ __forceinline__ void gemm_phase(PG8_LAS unsigned char* lds, const Gemm g, const Sched& S, const Epi& E) {
    int tid_ = threadIdx.x; asm volatile("" : "+v"(tid_));
    const int tid = tid_, wid = __builtin_amdgcn_readfirstlane(tid >> 6), lane = tid & 63, wr = wid >> 2, wc = wid & 3, fr = lane & 15, fq = lane >> 4;
    const int K = g.K, nt = K / BK;
    unsigned voffA[2], voffB[2];
#pragma unroll
    for (int i = 0; i < 2; ++i) { int R, C; stage_rc(tid * 16 + i * 8192, R, C); const int Rb = Epi::PERM ? ((R & ~31) + perm32(R & 31)) : R;
        voffA[i] = (unsigned)(R * K + C) * 2u; voffB[i] = (unsigned)(Rb * K + C) * 2u; }
    const size_t kstep = (size_t)(BK * 2);
    const size_t hstep = (size_t)HALF * K * 2;
    const size_t tstep = 2 * hstep;
    const unsigned ldsw = (unsigned)wid * 1024u;
    const int aoff = lds_byte(wr * 64 + fr, fq * 8), boff = lds_byte(wc * 32 + fr, fq * 8);
#define PG8_SA(b, h) (((b) * 2 + (h)) * HTB)
#define PG8_SB(b, h) ((4 + (b) * 2 + (h)) * HTB)
#define PG8_STAGE(bufoff, gbase, voff) do { _Pragma("unroll") for (int _i = 0; _i < 2; ++_i) \
        __builtin_amdgcn_global_load_lds((const unsigned*)((const char*)(gbase) + (voff)[_i]), (PG8_LAS unsigned*)(lds + (bufoff) + ldsw + _i * 8192), 16, 0, 0); } while (0)
#define PG8_LDA(dst, b, h) do { _Pragma("unroll") for (int m = 0; m < 4; ++m) _Pragma("unroll") for (int k = 0; k < 2; ++k) dst[m][k] = *(const PG8_LAS bf16x8*)(lds + PG8_SA(b, h) + aoff + m * 2048 + k * 1024); } while (0)
#define PG8_LDB(dst, b, h) do { _Pragma("unroll") for (int n = 0; n < 2; ++n) _Pragma("unroll") for (int k = 0; k < 2; ++k) dst[n][k] = *(const PG8_LAS bf16x8*)(lds + PG8_SB(b, h) + boff + n * 2048 + k * 1024); } while (0)
#define PG8_MMA(ai, bj, At, Bt) do { __builtin_amdgcn_s_setprio(1); _Pragma("unroll") for (int m = 0; m < 4; ++m) _Pragma("unroll") for (int n = 0; n < 2; ++n) _Pragma("unroll") for (int k = 0; k < 2; ++k) \
        acc[ai][bj][m][n] = __builtin_amdgcn_mfma_f32_16x16x32_bf16(Bt[n][k], At[m][k], acc[ai][bj][m][n], 0, 0, 0); __builtin_amdgcn_s_setprio(0); } while (0)
#define PG8_WAIT_V(n) asm volatile("s_waitcnt vmcnt(" #n ")" ::: "memory")
#define PG8_WAIT_L(n) asm volatile("s_waitcnt lgkmcnt(" #n ")" ::: "memory")
#define PG8_BAR __builtin_amdgcn_s_barrier()
#define PG8_SCHED __builtin_amdgcn_sched_barrier(0)
    Unit cur, nxt; int ui = 0;
    if (!S.next(0, cur)) return;
    f32x4 acc[2][2][4][2];
#pragma unroll
    for (int a = 0; a < 2; ++a)
#pragma unroll
        for (int b = 0; b < 2; ++b)
#pragma unroll
            for (int m = 0; m < 4; ++m)
#pragma unroll
                for (int n = 0; n < 2; ++n) acc[a][b][m][n] = (f32x4){0.f, 0.f, 0.f, 0.f};
    bf16x8 At[4][2], B0[2][2], B1[2][2];
    const char* cA = (const char*)g.A + (size_t)cur.pm * tstep; const char* cB = (const char*)g.Bt + (size_t)cur.pn * tstep;
    S.a_ready(cur);
    if constexpr (SP2) {
        PG8_STAGE(PG8_SB(0, 0), cB, voffB); PG8_STAGE(PG8_SB(0, 1), cB + hstep, voffB); PG8_STAGE(PG8_SA(0, 0), cA, voffA); PG8_STAGE(PG8_SA(0, 1), cA + hstep, voffA);
        if (wr == 1) PG8_BAR;
        PG8_WAIT_V(2); PG8_BAR;
        PG8_STAGE(PG8_SB(1, 0), cB + kstep, voffB); PG8_STAGE(PG8_SA(1, 0), cA + kstep, voffA); PG8_STAGE(PG8_SB(1, 1), cB + hstep + kstep, voffB);
        PG8_WAIT_V(6); PG8_BAR;
    } else {
        PG8_STAGE(PG8_SB(0, 0), cB, voffB); PG8_STAGE(PG8_SA(0, 0), cA, voffA); PG8_STAGE(PG8_SB(0, 1), cB + hstep, voffB); PG8_STAGE(PG8_SA(0, 1), cA + hstep, voffA);
        if (wr == 1) PG8_BAR;
        PG8_WAIT_V(4); PG8_BAR;
        PG8_STAGE(PG8_SB(1, 0), cB + kstep, voffB); PG8_STAGE(PG8_SA(1, 0), cA + kstep, voffA); PG8_STAGE(PG8_SB(1, 1), cB + hstep + kstep, voffB);
        PG8_WAIT_V(6); PG8_BAR;
    }
    for (;;) {
        const bool has_next = S.next(ui + 1, nxt);
        const char* nA = has_next ? (const char*)g.A + (size_t)nxt.pm * tstep : cA; const char* nB = has_next ? (const char*)g.Bt + (size_t)nxt.pn * tstep : cB;
        for (int t = 0; t < nt; t += 2) {
            const bool last = (t == nt - 2);
            const char* a1 = cA + (size_t)(t + 1) * kstep;
            const char* a2 = last ? nA : cA + (size_t)(t + 2) * kstep; const char* b2 = last ? nB : cB + (size_t)(t + 2) * kstep;
            const char* a3 = a2 + kstep; const char* b3 = b2 + kstep;
            if (last && has_next) S.a_ready(nxt);
            if constexpr (SP2) {
            PG8_LDB(B0, 0, 0); PG8_LDB(B1, 0, 1); PG8_SCHED; PG8_LDA(At, 0, 0); PG8_STAGE(PG8_SA(1, 1), a1 + hstep, voffA);
            PG8_WAIT_V(8); PG8_WAIT_L(0); PG8_BAR; PG8_MMA(0, 0, At, B0); PG8_MMA(0, 1, At, B1); PG8_BAR; PG8_SCHED;
            PG8_LDA(At, 0, 1); PG8_STAGE(PG8_SB(0, 0), b2, voffB); PG8_STAGE(PG8_SB(0, 1), b2 + hstep, voffB); PG8_STAGE(PG8_SA(0, 0), a2, voffA);
            PG8_WAIT_V(8); PG8_WAIT_L(0); PG8_BAR; PG8_MMA(1, 0, At, B0); PG8_MMA(1, 1, At, B1); PG8_BAR; PG8_SCHED;
            PG8_LDB(B0, 1, 0); PG8_LDB(B1, 1, 1); PG8_SCHED; PG8_LDA(At, 1, 0); PG8_STAGE(PG8_SA(0, 1), a2 + hstep, voffA);
            PG8_WAIT_V(8); PG8_WAIT_L(0); PG8_BAR; PG8_MMA(0, 0, At, B0); PG8_MMA(0, 1, At, B1); PG8_BAR; PG8_SCHED;
            PG8_LDA(At, 1, 1); PG8_STAGE(PG8_SB(1, 0), b3, voffB); PG8_STAGE(PG8_SB(1, 1), b3 + hstep, voffB); PG8_STAGE(PG8_SA(1, 0), a3, voffA);
            PG8_WAIT_V(8); PG8_WAIT_L(0); PG8_BAR; PG8_MMA(1, 0, At, B0); PG8_MMA(1, 1, At, B1); PG8_BAR; PG8_SCHED;
            } else {
            PG8_LDB(B0, 0, 0); PG8_SCHED; PG8_LDA(At, 0, 0); PG8_STAGE(PG8_SA(1, 1), a1 + hstep, voffA);
            PG8_WAIT_L(8); PG8_BAR; PG8_WAIT_L(0); PG8_MMA(0, 0, At, B0); PG8_BAR; PG8_SCHED;
            PG8_LDB(B1, 0, 1); PG8_STAGE(PG8_SB(0, 0), b2, voffB);
            PG8_BAR; PG8_WAIT_L(0); PG8_MMA(0, 1, At, B1); PG8_BAR;
            PG8_LDA(At, 0, 1); PG8_STAGE(PG8_SA(0, 0), a2, voffA);
            PG8_BAR; PG8_WAIT_L(0); PG8_MMA(1, 0, At, B0); PG8_BAR; PG8_SCHED;
            PG8_STAGE(PG8_SB(0, 1), b2 + hstep, voffB);
            PG8_WAIT_V(6); PG8_BAR; PG8_MMA(1, 1, At, B1); PG8_BAR;
            PG8_LDB(B0, 1, 0); PG8_SCHED; PG8_LDA(At, 1, 0); PG8_STAGE(PG8_SA(0, 1), a2 + hstep, voffA);
            PG8_WAIT_L(8); PG8_BAR; PG8_WAIT_L(0); PG8_MMA(0, 0, At, B0); PG8_BAR; PG8_SCHED;
            PG8_LDB(B1, 1, 1); PG8_STAGE(PG8_SB(1, 0), b3, voffB);
            PG8_BAR; PG8_WAIT_L(0); PG8_MMA(0, 1, At, B1); PG8_BAR;
            PG8_LDA(At, 1, 1); PG8_STAGE(PG8_SA(1, 0), a3, voffA);
            PG8_BAR; PG8_WAIT_L(0); PG8_MMA(1, 0, At, B0); PG8_BAR; PG8_SCHED;
            PG8_STAGE(PG8_SB(1, 1), b3 + hstep, voffB);
            PG8_WAIT_V(6); PG8_BAR; PG8_MMA(1, 1, At, B1); PG8_BAR;
            }
        }
        if constexpr (ALIGN_EPI) { if (wr == 0) PG8_BAR; }
        if constexpr (!Epi::AFTER_DRAIN) { E(acc, cur, wr, wc, fr, fq); S.done(cur); }
        if (!has_next) break;
#pragma unroll
        for (int a = 0; a < 2; ++a)
#pragma unroll
            for (int b = 0; b < 2; ++b)
#pragma unroll
                for (int m = 0; m < 4; ++m)
#pragma unroll
                    for (int n = 0; n < 2; ++n) acc[a][b][m][n] = (f32x4){0.f, 0.f, 0.f, 0.f};
        cur = nxt; cA = nA; cB = nB; ++ui;
        if constexpr (ALIGN_EPI) { if (wr == 1) PG8_BAR; }
    }
    PG8_WAIT_V(0);
    if constexpr (!ALIGN_EPI) { if (wr == 0) PG8_BAR; }
    PG8_BAR;
    if constexpr (Epi::AFTER_DRAIN) { E.fused(acc, cur, wr, wc, fr, fq, lds, wid, lane); S.done(cur); }
#undef PG8_SA
#undef PG8_SB
#undef PG8_STAGE
#undef PG8_LDA
#undef PG8_LDB
#undef PG8_MMA
#undef PG8_WAIT_V
#undef PG8_WAIT_L
#undef PG8_BAR
#undef PG8_SCHED
}
}
constexpr int BATCH = 8, SEQ = 4096, DM = 1024, DEPTH = 2, MTOK = BATCH * SEQ;
constexpr int NQKV = 1536, NU2 = 1024, FF = 2816, NGU = 2 * FF, NHEAD = 8;
constexpr float LN_EPS = 1e-5f, SUBLN_EPS = 1e-5f;
constexpr float ALPHA = 1.4142135623730951f;
constexpr float QSCALE = 0.17677669529663687f * 1.4426950408889634f;
constexpr int NWAVES = 8, NTHREADS = 512;

typedef unsigned short bf16_t;
typedef short bf16x8 __attribute__((ext_vector_type(8)));
typedef short s16x4 __attribute__((ext_vector_type(4)));
typedef float f32x4 __attribute__((ext_vector_type(4)));
typedef float f32x16 __attribute__((ext_vector_type(16)));
typedef unsigned u32x4 __attribute__((ext_vector_type(4)));
typedef unsigned u32x2 __attribute__((ext_vector_type(2)));
#define LAS __attribute__((address_space(3)))

constexpr size_t MiB = 1u << 20;
constexpr size_t WS_CTL = 0;
constexpr size_t WS_W = 2 * MiB, W_LAYER = 24 * MiB;
constexpr size_t W_QKV = 0, W_U = 3 * MiB, W_O = 5 * MiB, W_GU = 7 * MiB, W_D = 18 * MiB, W_BO = 23 * MiB + 512 * 1024;
constexpr size_t WS_DMAT = 50 * MiB;
constexpr size_t WS_XN = 114 * MiB;
constexpr size_t WS_H = 178 * MiB;
constexpr size_t WS_QKV = 306 * MiB;
constexpr size_t WS_XT = 402 * MiB;
constexpr size_t WS_ACT = 306 * MiB;
constexpr size_t WS_END = 482 * MiB;

struct Args { const float* in[15]; float* out; unsigned char* ws; };

__device__ __forceinline__ unsigned f2bf(float f) { unsigned u = __builtin_bit_cast(unsigned, f); return (u + 0x7fffu + ((u >> 16) & 1u)) >> 16; }
__device__ __forceinline__ unsigned pk2(float lo, float hi) { return f2bf(lo) | (f2bf(hi) << 16); }
__device__ __forceinline__ float wave_sum(float v) {
#pragma unroll
    for (int o = 1; o < 64; o <<= 1) v += __shfl_xor(v, o);
    return v;
}

__device__ __forceinline__ void tr_item(const float* W, int ldw, bf16_t* WT, int ldt, int k0, int n0, int mode, float scale, LAS float* scr, int lane) {
#pragma unroll 8
    for (int i = 0; i < 32; ++i) { const int kk = 2 * i + (lane >> 5); scr[kk * 33 + (lane & 31)] = W[(size_t)(k0 + kk) * ldw + n0 + (lane & 31)] * scale; }
    asm volatile("s_waitcnt lgkmcnt(0)" ::: "memory");
    int r0 = n0;
    if (mode == 1) { const int part = n0 >= FF ? 1 : 0; const int ff = n0 - part * FF; r0 = (ff >> 7) * 256 + part * 128 + (ff & 127); }
    const int c = lane & 7;
#pragma unroll
    for (int j = 0; j < 4; ++j) { const int n = (lane >> 3) + 8 * j; const LAS float* s = scr + (8 * c) * 33 + n;
        u32x4 o; o.x = pk2(s[0 * 33], s[1 * 33]); o.y = pk2(s[2 * 33], s[3 * 33]); o.z = pk2(s[4 * 33], s[5 * 33]); o.w = pk2(s[6 * 33], s[7 * 33]);
        *(u32x4*)(WT + (size_t)(r0 + n) * ldt + k0 + 8 * c) = o; }
    asm volatile("s_waitcnt lgkmcnt(0)" ::: "memory");
}
__device__ __forceinline__ void ln_row(const float* src, const float* g, const float* bta, float* dstf, bf16_t* dstb, int lane) {
    const f32x4* xr = (const f32x4*)src + lane;
    f32x4 v[4]; float s = 0.f;
#pragma unroll
    for (int j = 0; j < 4; ++j) { v[j] = xr[64 * j]; s += (v[j].x + v[j].y) + (v[j].z + v[j].w); }
    const float mean = wave_sum(s) * (1.f / DM); float s2 = 0.f;
#pragma unroll
    for (int j = 0; j < 4; ++j) { v[j] = v[j] - mean; s2 += (v[j].x * v[j].x + v[j].y * v[j].y) + (v[j].z * v[j].z + v[j].w * v[j].w); }
    const float rstd = 1.f / sqrtf(wave_sum(s2) * (1.f / DM) + LN_EPS);
#pragma unroll
    for (int j = 0; j < 4; ++j) { const f32x4 gg = ((const f32x4*)g)[lane + 64 * j], bb = ((const f32x4*)bta)[lane + 64 * j];
        const f32x4 o = v[j] * rstd * gg + bb;
        if (dstf) ((f32x4*)dstf)[lane + 64 * j] = o;
        u32x2 w; w.x = pk2(o.x, o.y); w.y = pk2(o.z, o.w); ((u32x2*)dstb)[lane + 64 * j] = w; }
}

__device__ __forceinline__ int crow(int r, int hi) { return (r & 3) + 8 * (r >> 2) + 4 * hi; }
__device__ __forceinline__ bf16x8 vfrag(const LAS unsigned char* p) {
    typedef short v4s __attribute__((ext_vector_type(4)));
    const v4s lo = __builtin_amdgcn_ds_read_tr16_b64_v4i16((LAS v4s*)p), hi = __builtin_amdgcn_ds_read_tr16_b64_v4i16((LAS v4s*)(p + 512));
    return (bf16x8){lo[0], lo[1], lo[2], lo[3], hi[0], hi[1], hi[2], hi[3]};
}
__device__ __forceinline__ int attn_tile_of(int idx, int tq, int nL) { return idx < 4 ? tq + idx : (idx < 4 + nL ? tq + 3 - idx : tq + idx - nL); }
constexpr float ATT_SKIP_T = 32.0f;
constexpr float ATT_THR = 16.0f;
constexpr int ATT_TILE = 16384;
constexpr int ATT_QOFF = 3 * ATT_TILE;
__device__ __forceinline__ void attn_qk(f32x16 (&s)[2], const LAS unsigned char* tl, const LAS unsigned char* ql, int kof0, const f32x16& cb0, bool diag, float tb, float slope2, float mref, float delta) {
    const int kof1 = kof0 ^ 32;
    const bf16x8 k00 = *(const LAS bf16x8*)(tl + kof0), k01 = *(const LAS bf16x8*)(tl + kof0 + 4096), k10 = *(const LAS bf16x8*)(tl + kof1), k11 = *(const LAS bf16x8*)(tl + kof1 + 4096);
    const bf16x8 q0 = *(const LAS bf16x8*)(ql + kof0), q1 = *(const LAS bf16x8*)(ql + kof1);
    f32x16 c1;
    if (diag) {
#pragma unroll
        for (int r = 0; r < 16; ++r) c1[r] = -slope2 * __builtin_fabsf(tb + (float)(32 + (r & 3) + 8 * (r >> 2))) - mref;
    } else {
#pragma unroll
        for (int r = 0; r < 16; ++r) c1[r] = cb0[r] + delta;
    }
    s[0] = __builtin_amdgcn_mfma_f32_32x32x16_bf16(k00, q0, cb0, 0, 0, 0); s[1] = __builtin_amdgcn_mfma_f32_32x32x16_bf16(k01, q0, c1, 0, 0, 0);
    s[0] = __builtin_amdgcn_mfma_f32_32x32x16_bf16(k10, q1, s[0], 0, 0, 0); s[1] = __builtin_amdgcn_mfma_f32_32x32x16_bf16(k11, q1, s[1], 0, 0, 0);
}
template <int VAR>
__device__ __forceinline__ void attn_softmax(f32x16 (&s)[2], u32x4 (&pf)[4], f32x16 (&so)[2], f32x16& cb0, f32x16 (&o)[2][2], float& mref, float (&lrow)[2], float& lsum, bool first) {
    if (VAR != 7) {
    float ma = __builtin_fmaxf(s[0][0], s[1][0]), mb = __builtin_fmaxf(s[0][1], s[1][1]), mc = __builtin_fmaxf(s[0][2], s[1][2]), md = __builtin_fmaxf(s[0][3], s[1][3]);
#pragma unroll
    for (int r = 4; r < 16; r += 4) { ma = __builtin_fmaxf(__builtin_fmaxf(ma, s[0][r]), s[1][r]); mb = __builtin_fmaxf(__builtin_fmaxf(mb, s[0][r + 1]), s[1][r + 1]);
        mc = __builtin_fmaxf(__builtin_fmaxf(mc, s[0][r + 2]), s[1][r + 2]); md = __builtin_fmaxf(__builtin_fmaxf(md, s[0][r + 3]), s[1][r + 3]); }
    float mx = __builtin_fmaxf(__builtin_fmaxf(ma, mb), __builtin_fmaxf(mc, md));
    mx = __builtin_fmaxf(mx, __shfl_xor(mx, 32));
    if (first || __any(mx > ATT_THR)) {
        const float dl = first ? mx : __builtin_fmaxf(mx, 0.f), f = first ? 1.0f : __builtin_amdgcn_exp2f(-dl);
        mref += dl; lrow[0] *= f; lrow[1] *= f;
#pragma unroll
        for (int r = 0; r < 16; ++r) { s[0][r] -= dl; s[1][r] -= dl; cb0[r] -= dl; so[0][r] -= dl; so[1][r] -= dl;
            o[0][0][r] *= f; o[0][1][r] *= f; o[1][0][r] *= f; o[1][1][r] *= f; }
    }
    float ra = 0.f, rb = 0.f;
#pragma unroll
    for (int r = 0; r < 16; ++r) { if (VAR == 3) { s[0][r] = s[0][r] * 0.5f; s[1][r] = s[1][r] * 0.5f; } else { s[0][r] = __builtin_amdgcn_exp2f(s[0][r]); s[1][r] = __builtin_amdgcn_exp2f(s[1][r]); } ra += s[0][r]; rb += s[1][r]; }
    lsum += ra + rb;
    }
    pf[0] = (u32x4){pg8::cvt_pk_bf16(s[0][0], s[0][1]), pg8::cvt_pk_bf16(s[0][2], s[0][3]), pg8::cvt_pk_bf16(s[0][4], s[0][5]), pg8::cvt_pk_bf16(s[0][6], s[0][7])};
    pf[1] = (u32x4){pg8::cvt_pk_bf16(s[0][8], s[0][9]), pg8::cvt_pk_bf16(s[0][10], s[0][11]), pg8::cvt_pk_bf16(s[0][12], s[0][13]), pg8::cvt_pk_bf16(s[0][14], s[0][15])};
    pf[2] = (u32x4){pg8::cvt_pk_bf16(s[1][0], s[1][1]), pg8::cvt_pk_bf16(s[1][2], s[1][3]), pg8::cvt_pk_bf16(s[1][4], s[1][5]), pg8::cvt_pk_bf16(s[1][6], s[1][7])};
    pf[3] = (u32x4){pg8::cvt_pk_bf16(s[1][8], s[1][9]), pg8::cvt_pk_bf16(s[1][10], s[1][11]), pg8::cvt_pk_bf16(s[1][12], s[1][13]), pg8::cvt_pk_bf16(s[1][14], s[1][15])};
}
#define ATT_VTR(dst, addr, off) asm volatile("ds_read_b64_tr_b16 %0, %1 offset:%2" : "=v"(dst) : "v"(addr), "i"(off))
__device__ __forceinline__ void attn_vload(s16x4 (&vlo)[8], s16x4 (&vhi)[8], unsigned va) {
    ATT_VTR(vlo[0], va, 0);    ATT_VTR(vhi[0], va, 512);  ATT_VTR(vlo[1], va, 1024); ATT_VTR(vhi[1], va, 1536);
    ATT_VTR(vlo[2], va, 2048); ATT_VTR(vhi[2], va, 2560); ATT_VTR(vlo[3], va, 3072); ATT_VTR(vhi[3], va, 3584);
    ATT_VTR(vlo[4], va, 4096); ATT_VTR(vhi[4], va, 4608); ATT_VTR(vlo[5], va, 5120); ATT_VTR(vhi[5], va, 5632);
    ATT_VTR(vlo[6], va, 6144); ATT_VTR(vhi[6], va, 6656); ATT_VTR(vlo[7], va, 7168); ATT_VTR(vhi[7], va, 7680);
}
__device__ __forceinline__ void attn_pv(f32x16 (&oc)[2], const u32x4 (&pf)[4], const s16x4 (&vlo)[8], const s16x4 (&vhi)[8]) {
#pragma unroll
    for (int d = 0; d < 2; ++d)
#pragma unroll
        for (int s4 = 0; s4 < 4; ++s4) { const s16x4 a = vlo[d * 4 + s4], b = vhi[d * 4 + s4]; const bf16x8 vf = (bf16x8){a[0], a[1], a[2], a[3], b[0], b[1], b[2], b[3]};
            oc[d] = __builtin_amdgcn_mfma_f32_32x32x16_bf16(vf, __builtin_bit_cast(bf16x8, pf[s4]), oc[d], 0, 0, 0); }
}
template <int VAR>
__device__ __forceinline__ void attn_unit(int b, int h, int qb, const bf16_t* QKV, bf16_t* AF, float lam, float oscale, const float* subg, const unsigned* kmax, LAS unsigned char* lds) {
    int tid_ = threadIdx.x; asm volatile("" : "+v"(tid_));
    const int tid = tid_, lane = tid & 63, r32 = lane & 31, hi = lane >> 5; const int wid = __builtin_amdgcn_readfirstlane(tid >> 6);
    const size_t rowbase = (size_t)b * SEQ; const int q0 = qb * 256 + wid * 32, tq = qb * 4;
    const float slope2 = __builtin_amdgcn_exp2f(-(float)(h + 1)) * 1.4426950408889634f;
    const int kkey = 8 * wid + (lane >> 3);
    const bf16_t* kg = QKV + (rowbase + kkey) * NQKV + 512 + h * 64 + (((lane & 7) ^ ((kkey >> 1) & 7)) << 3);
    const bf16_t* vg = QKV + (rowbase + 16 * (wid & 3) + 8 * (lane >> 5) + ((lane >> 2) & 7)) * NQKV + 1024 + h * 64 + 32 * (wid >> 2) + 8 * (lane & 3);
#define ATT_DMA_TILE(t, slot) do { __builtin_amdgcn_global_load_lds((const unsigned*)(kg + (size_t)(t) * 64 * NQKV), (LAS unsigned*)(lds + (slot) + wid * 1024), 16, 0, 0); \
                                   __builtin_amdgcn_global_load_lds((const unsigned*)(vg + (size_t)(t) * 64 * NQKV), (LAS unsigned*)(lds + (slot) + 8192 + wid * 1024), 16, 0, 0); } while (0)
    { const bf16_t* qg = kg - 512 + (size_t)(qb * 256) * NQKV;
#pragma unroll
      for (int p = 0; p < 4; ++p) __builtin_amdgcn_global_load_lds((const unsigned*)(qg + (size_t)p * 64 * NQKV), (LAS unsigned*)(lds + ATT_QOFF + p * 8192 + wid * 1024), 16, 0, 0); }
    ATT_DMA_TILE(tq, 0);
    const int kofA = r32 * 128 + ((hi ^ ((r32 >> 1) & 7)) << 4), kofB = kofA ^ 64;
    const LAS unsigned char* ql = lds + ATT_QOFF + wid * 4096;
    const int vrb = 8192 + ((lane >> 4) & 1) * 32 + (lane & 3) * 8 + (4 * hi + ((lane & 15) >> 2)) * 64;
    f32x16 o[2][2], cb0, sA[2], sB[2]; float mref = 0.f, lrow[2] = {0.f, 0.f};
#pragma unroll
    for (int d = 0; d < 2; ++d)
#pragma unroll
        for (int r = 0; r < 16; ++r) { o[0][d][r] = 0.f; o[1][d][r] = 0.f; }
    const float kb0 = (float)(4 * hi) - (float)(q0 + r32);
    const float step = -64.0f * slope2;
    asm volatile("s_waitcnt vmcnt(0)" ::: "memory");
    __syncthreads();
    int nL, nR;
    {
        const int qrow = tid >> 1, qc = tid & 1; float qs = 0.f;
#pragma unroll
        for (int ch = 0; ch < 4; ++ch) { const bf16x8 v = *(const LAS bf16x8*)(lds + ATT_QOFF + qrow * 128 + (((4 * qc + ch) ^ ((qrow >> 1) & 7)) << 4));
#pragma unroll
            for (int e = 0; e < 8; ++e) { const float f = __uint_as_float(((unsigned)(unsigned short)v[e]) << 16); qs += f * f; } }
#pragma unroll
        for (int of = 1; of < 64; of <<= 1) qs = __builtin_fmaxf(qs, __shfl_xor(qs, of));
        LAS float* red = (LAS float*)(lds + ATT_QOFF + 32768);
        if (lane == 0) red[wid] = qs;
        __syncthreads();
        float q2 = red[0];
#pragma unroll
        for (int w = 1; w < 8; ++w) q2 = __builtin_fmaxf(q2, red[w]);
        const float k2 = __uint_as_float(__hip_atomic_load(kmax + b * 8 + h, __ATOMIC_RELAXED, __HIP_MEMORY_SCOPE_AGENT));
        const float X = sqrtf(q2 * k2) * 1.02f;
        const float Df = (ATT_SKIP_T + 2.0f * X) / slope2;
        const int D = Df < 8192.f ? (int)Df + 1 : 8192;
        nL = min(tq, (D + 62) >> 6); nR = min(60 - tq, ((D - 2) >> 6) + 1);
        nL = __builtin_amdgcn_readfirstlane(nL); nR = __builtin_amdgcn_readfirstlane(nR);
    }
    const int NT = 4 + nL + nR;
    ATT_DMA_TILE(attn_tile_of(1, tq, nL), ATT_TILE);
    float tb = kb0 + (float)(tq * 64);
#pragma unroll
    for (int r = 0; r < 16; ++r) cb0[r] = -slope2 * __builtin_fabsf(tb + (float)((r & 3) + 8 * (r >> 2)));
    attn_qk(sA, lds, ql, kofA, cb0, true, tb, slope2, 0.f, 0.f);
    int bcur = 0;
#pragma unroll 1
    for (int idx = 0; idx < NT; ++idx) {
        const int bnxt = (bcur == 2 * ATT_TILE) ? 0 : bcur + ATT_TILE, bnn = (bnxt == 2 * ATT_TILE) ? 0 : bnxt + ATT_TILE;
        asm volatile("s_waitcnt vmcnt(0)" ::: "memory");
        __syncthreads();
        if (idx + 2 < NT) ATT_DMA_TILE(attn_tile_of(idx + 2, tq, nL), bnn);
        const float delta = (idx < 4 + nL) ? 32.f * slope2 : -32.f * slope2;
        u32x4 pf[4];
        s16x4 vlo[8], vhi[8];
        attn_qk(sB, lds + bcur, ql, kofB, cb0, idx < 4, tb, slope2, mref, delta);
        __builtin_amdgcn_sched_barrier(0);
        if (VAR != 5) attn_vload(vlo, vhi, (unsigned)(bcur + vrb));
        attn_softmax<VAR>(sA, pf, sB, cb0, o, mref, lrow, lrow[0], idx == 0);
        asm volatile("s_waitcnt lgkmcnt(0)" ::: "memory"); __builtin_amdgcn_sched_barrier(0);
        if (VAR != 4 && VAR != 5) attn_pv(o[0], pf, vlo, vhi); else { asm volatile("" :: "v"(pf[0]), "v"(pf[1]), "v"(pf[2]), "v"(pf[3])); }
        const bool nform = (idx + 1 <= 4) || (idx + 1 == 4 + nL);
        if (nform) {
            tb = kb0 + (float)(attn_tile_of(idx + 1, tq, nL) * 64);
#pragma unroll
            for (int r = 0; r < 16; ++r) cb0[r] = -slope2 * __builtin_fabsf(tb + (float)((r & 3) + 8 * (r >> 2))) - mref;
        } else {
#pragma unroll
            for (int r = 0; r < 16; ++r) cb0[r] += step;
        }
        const float deltan = (idx + 1 < 4 + nL) ? 32.f * slope2 : -32.f * slope2;
        if (idx + 1 < NT) attn_qk(sA, lds + bnxt, ql, kofA, cb0, idx + 1 < 4, tb, slope2, mref, deltan);
        __builtin_amdgcn_sched_barrier(0);
        if (VAR != 5) attn_vload(vlo, vhi, (unsigned)(bcur + vrb));
        attn_softmax<VAR>(sB, pf, sA, cb0, o, mref, lrow, lrow[1], false);
        asm volatile("s_waitcnt lgkmcnt(0)" ::: "memory"); __builtin_amdgcn_sched_barrier(0);
        if (VAR != 4 && VAR != 5) attn_pv(o[1], pf, vlo, vhi); else { asm volatile("" :: "v"(pf[0]), "v"(pf[1]), "v"(pf[2]), "v"(pf[3])); }
        bcur = bnxt;
    }
    float inv[2];
#pragma unroll
    for (int c = 0; c < 2; ++c) { const float lt = lrow[c] + __shfl_xor(lrow[c], 32); inv[c] = 1.0f / lt; }
    const float w1 = lam * inv[1];
    float ss = 0.f;
#pragma unroll
    for (int d = 0; d < 2; ++d)
#pragma unroll
        for (int r = 0; r < 16; ++r) { const float v = o[0][d][r] * inv[0] - o[1][d][r] * w1; o[0][d][r] = v; ss += v * v; }
    ss += __shfl_xor(ss, 32);
    const float sc = oscale / sqrtf(ss * (1.0f / 64.0f) + SUBLN_EPS);
    bf16_t* orow = AF + (rowbase + q0 + r32) * 1024 + h * 64;
#pragma unroll
    for (int d = 0; d < 2; ++d)
#pragma unroll
        for (int g4 = 0; g4 < 4; ++g4) { const int dc = 32 * d + 8 * g4 + 4 * hi; const f32x4 gg = *(const f32x4*)(subg + dc);
            u32x2 w; w.x = pg8::cvt_pk_bf16(o[0][d][4 * g4] * sc * gg[0], o[0][d][4 * g4 + 1] * sc * gg[1]); w.y = pg8::cvt_pk_bf16(o[0][d][4 * g4 + 2] * sc * gg[2], o[0][d][4 * g4 + 3] * sc * gg[3]);
            *(u32x2*)(orow + dc) = w; }
    __syncthreads();
#undef ATT_DMA_TILE
}

#define RLX_AGENT __ATOMIC_RELAXED, __HIP_MEMORY_SCOPE_AGENT
constexpr int CW_KMAX = 1024;
constexpr int CW_BAR = 4096;
#define XB_TMO      128
#define XB_XCNT(j)  (256  + 64 * (j))
#define XB_XSUB(j)  (1280 + 64 * (j))
#define XB_XGEN(j)  (2304 + 64 * (j))
#define XB_TOP      3328
#define XB_TOPGEN   3392
#define XCD_BAR_WORDS 3456
#define XB_SPIN_CAP (1u << 18)

__device__ __forceinline__ unsigned xb_ld(unsigned* p)              { return __hip_atomic_load(p, __ATOMIC_RELAXED, __HIP_MEMORY_SCOPE_AGENT); }
__device__ __forceinline__ unsigned xb_add(unsigned* p, unsigned v) { return __hip_atomic_fetch_add(p, v, __ATOMIC_RELAXED, __HIP_MEMORY_SCOPE_AGENT); }
__device__ __forceinline__ unsigned xb_xcc_id() { return (unsigned)__builtin_amdgcn_s_getreg((3 << 11) | 20) & 0xFu; }
#define XB_SPIN(cond, bar) do { unsigned _sp = 0; while (cond) { __builtin_amdgcn_s_sleep(1); \
    if ((++_sp & 255u) == 0u) { if (xb_ld(&(bar)[XB_TMO])) break; if (_sp > XB_SPIN_CAP) { atomicAdd(&(bar)[XB_TMO], 1u); break; } } } } while (0)

struct XcdBarrier {
    unsigned* bar; unsigned x;
    volatile LAS unsigned* st;
};

__device__ __forceinline__ XcdBarrier xcd_barrier_post(unsigned* bar, volatile LAS unsigned* st) {
    XcdBarrier b; b.bar = bar; b.x = xb_xcc_id(); b.st = st;
    if (threadIdx.x == 0) (void)xb_add(&bar[XB_XCNT(b.x)], 1u);
    return b;
}
__device__ __forceinline__ void xcd_barrier_complete(unsigned* bar, unsigned x, unsigned& nloc, unsigned& nx) {
    const unsigned G = gridDim.x * gridDim.y * gridDim.z;
    unsigned sum, cnt, mine, sp = 0u;
    for (;;) {
        sum = 0u; cnt = 0u; mine = 0u;
#pragma unroll
        for (unsigned j = 0; j < 16; ++j) { const unsigned c = xb_ld(&bar[XB_XCNT(j)]); sum += c; cnt += (c > 0u) ? 1u : 0u; mine = (j == x) ? c : mine; }
        if (sum == G) break;
        __builtin_amdgcn_s_sleep(1);
        if ((++sp & 255u) == 0u) { if (xb_ld(&bar[XB_TMO])) break; if (sp > XB_SPIN_CAP) { atomicAdd(&bar[XB_TMO], 1u); break; } }
    }
    nloc = mine > 0u ? mine : 1u; nx = cnt > 0u ? cnt : 1u;
}

__device__ __forceinline__ void xcd_barrier(const XcdBarrier& b) {
    asm volatile("s_waitcnt vmcnt(0)" ::: "memory");
    __syncthreads();
    if (threadIdx.x == 0) {
        unsigned* bar = b.bar;
        __builtin_amdgcn_s_waitcnt(0);
        unsigned nloc = b.st[0], nx = b.st[1];
        if (nloc == 0u) { xcd_barrier_complete(bar, b.x, nloc, nx); b.st[0] = nloc; b.st[1] = nx; }
        const unsigned old = xb_add(&bar[XB_XSUB(b.x)], 1u);
        const unsigned gen = old / nloc;
        if (old + 1u == (gen + 1u) * nloc) {
            __builtin_amdgcn_fence(__ATOMIC_RELEASE, "agent");
            asm volatile("s_waitcnt vmcnt(0)" ::: "memory");
            const unsigned og = xb_add(&bar[XB_TOP], 1u);
            const unsigned tg = og / nx;
            if (og + 1u == (tg + 1u) * nx) xb_add(&bar[XB_TOPGEN], 1u);
            else XB_SPIN(xb_ld(&bar[XB_TOPGEN]) == tg, bar);
            __builtin_amdgcn_fence(__ATOMIC_ACQUIRE, "agent");
            xb_add(&bar[XB_XGEN(b.x)], 1u);
            asm volatile("s_waitcnt vmcnt(0)" ::: "memory");
        } else {
            XB_SPIN(xb_ld(&bar[XB_XGEN(b.x)]) == gen, bar);
            __builtin_amdgcn_fence(__ATOMIC_ACQUIRE, "agent");
            asm volatile("s_waitcnt vmcnt(0)" ::: "memory");
        }
    }
    __syncthreads();
}


#ifndef PH_MASK
#define PH_MASK 0xFFFF
#endif
#define PH(k) if constexpr ((PH_MASK >> (k)) & 1)
#ifndef REP_MASK
#define REP_MASK 0
#endif
#define REP(k) for (int rep_ = 0; rep_ < ((((REP_MASK) >> (k)) & 1) ? 2 : 1); ++rep_)
#define GRID_SYNC_CG() do { __threadfence(); grid.sync(); } while (0)
#define GRID_SYNC() xcd_barrier(bar)
__global__ void __launch_bounds__(NTHREADS, 2) fwd_megakernel(Args args) {
    extern __shared__ __attribute__((aligned(16))) unsigned char lds_raw[];
    cg::grid_group grid = cg::this_grid();
    LAS unsigned char* lds = (LAS unsigned char*)lds_raw;
    const int G = gridDim.x, bx = blockIdx.x;
    const int vcu = (G % 8 == 0) ? (bx % 8) * (G / 8) + bx / 8 : bx;
    const int NGW = G * NWAVES;
#define LANE_VARS int tid_ = threadIdx.x; asm volatile("" : "+v"(tid_)); const int tid = tid_, lane = tid & 63, wave = __builtin_amdgcn_readfirstlane(tid >> 6), gw = vcu * NWAVES + wave; (void)tid; (void)lane; (void)gw;
    unsigned char* ws = args.ws;
    volatile LAS unsigned* MISC = (volatile LAS unsigned*)(lds + 131072);
    if (threadIdx.x < 64) MISC[threadIdx.x] = 0u;
    __syncthreads();
    XcdBarrier bar = xcd_barrier_post((unsigned*)(ws + WS_CTL) + CW_BAR, MISC + 8);
    const float* x = args.in[0]; const float* ln_in_g = args.in[1]; const float* ln_in_b = args.in[2]; const float* w_in = args.in[3];
    const float* lam_params = args.in[4]; const float* subln_g = args.in[5]; const float* w_f = args.in[6]; const float* b_f = args.in[7];
    const float* w_o = args.in[8]; const float* ln1_g = args.in[9]; const float* ln1_b = args.in[10]; const float* w_gu = args.in[11];
    const float* w_down = args.in[12]; const float* ln2_g = args.in[13]; const float* ln2_b = args.in[14];
    bf16_t* XN = (bf16_t*)(ws + WS_XN); bf16_t* AF = XN; float* H = (float*)(ws + WS_H); float* PRE = args.out;
    bf16_t* QKV = (bf16_t*)(ws + WS_QKV); bf16_t* XT = (bf16_t*)(ws + WS_XT); bf16_t* ACT = (bf16_t*)(ws + WS_ACT); bf16_t* DMAT = (bf16_t*)(ws + WS_DMAT);

    PH(0) REP(0) {
        LANE_VARS
        LAS float* scr = (LAS float*)(lds + wave * 8704);
        LAS float* tabc = (LAS float*)(lds + 8 * 8704); LAS float* tabs = tabc + 128;
        if (tid < 128) { const float a = (float)tid * (1.0f / 128.0f); tabc[tid] = __builtin_amdgcn_cosf(a) * 0.08838834764831845f; tabs[tid] = __builtin_amdgcn_sinf(a) * 0.08838834764831845f; }
        __syncthreads();
        constexpr int I_QKV = 16 * 48, I_O = 8 * 32, I_GU = 16 * 176, I_D = 44 * 32, I_L = I_QKV + I_O + I_GU + I_D;
        for (int it = gw; it < DEPTH * I_L; it += NGW) {
            const int l = it / I_L; int r = it % I_L; unsigned char* wl = ws + WS_W + (size_t)l * W_LAYER;
            if (r < I_QKV) { const int kb = r / 48, nb = r % 48; tr_item(w_in + (size_t)l * DM * 2048, 2048, (bf16_t*)(wl + W_QKV), DM, 64 * kb, 32 * nb, 0, nb < 16 ? QSCALE : 1.0f, scr, lane); continue; } r -= I_QKV;
            if (r < I_O) { const int kb = r / 32, nb = r % 32; tr_item(w_o + (size_t)l * DM * DM, DM, (bf16_t*)(wl + W_O), DM, 64 * kb, 32 * nb, 0, 1.0f, scr, lane); continue; } r -= I_O;
            if (r < I_GU) { const int kb = r / 176, nb = r % 176; tr_item(w_gu + (size_t)l * DM * NGU, NGU, (bf16_t*)(wl + W_GU), DM, 64 * kb, 32 * nb, 1, 1.0f, scr, lane); continue; } r -= I_GU;
            { const int kb = r / 32, nb = r % 32; tr_item(w_down + (size_t)l * FF * DM, DM, (bf16_t*)(wl + W_D), FF, 64 * kb, 32 * nb, 0, 1.0f, scr, lane); }
        }
        for (int it = gw; it < DEPTH * 1024; it += NGW) {
            const int l = it >> 10, r = it & 1023, g = r >> 8, kb = (r >> 4) & 15, cb = r & 15;
            const float* src = w_in + (size_t)l * DM * 2048 + (size_t)(64 * kb + lane) * 2048 + 1536 + 128 * g;
            float ac[8], as[8];
#pragma unroll
            for (int j = 0; j < 8; ++j) { ac[j] = 0.f; as[j] = 0.f; }
            for (int c4 = 0; c4 < 32; ++c4) { const f32x4 w = *(const f32x4*)(src + 4 * c4);
#pragma unroll
                for (int e = 0; e < 4; ++e) { const int c = 4 * c4 + e;
#pragma unroll
                    for (int j = 0; j < 8; ++j) { const int idx = (c * (8 * cb + j)) & 127; ac[j] += w[e] * tabc[idx]; as[j] += w[e] * tabs[idx]; } } }
            bf16_t* dst = (bf16_t*)(ws + WS_W + (size_t)l * W_LAYER + W_U);
#pragma unroll
            for (int j = 0; j < 8; ++j) { const int ch = 128 * g + 8 * cb + j;
                dst[(size_t)(2 * ch) * DM + 64 * kb + lane] = (bf16_t)f2bf(ac[j]); dst[(size_t)(2 * ch + 1) * DM + 64 * kb + lane] = (bf16_t)f2bf(as[j]); }
        }
        for (int it = gw; it < DEPTH * 1024; it += NGW) {
            const int l = it >> 10, r = it & 1023, g = r >> 8, nb = (r >> 4) & 15, cb = r & 15;
            const float* wo = w_o + (size_t)l * DM * DM + (size_t)(512 + 128 * g) * DM + 64 * nb + lane;
            const float* wf = w_f + (size_t)l * 4 * 128 * 128 + (size_t)g * 128 * 128 + (size_t)(8 * cb) * 128;
            float a8[8];
#pragma unroll
            for (int j = 0; j < 8; ++j) a8[j] = 0.f;
            for (int d = 0; d < 128; ++d) { const float w = wo[(size_t)d * DM];
#pragma unroll
                for (int j = 0; j < 8; ++j) a8[j] += wf[j * 128 + d] * w; }
            u32x4 o; o.x = pk2(a8[0], a8[1]); o.y = pk2(a8[2], a8[3]); o.z = pk2(a8[4], a8[5]); o.w = pk2(a8[6], a8[7]);
            *(u32x4*)((bf16_t*)(ws + WS_W + (size_t)l * W_LAYER + W_O) + (size_t)(64 * nb + lane) * DM + 512 + 128 * g + 8 * cb) = o;
        }
        for (int it = gw; it < DEPTH * 16; it += NGW) {
            const int l = it >> 4, nb = it & 15; const float* wo = w_o + (size_t)l * DM * DM + (size_t)512 * DM + 64 * nb + lane; const float* bf = b_f + l * 512;
            float a = 0.f; for (int j = 0; j < 512; ++j) a += bf[j] * wo[(size_t)j * DM];
            ((float*)(ws + WS_W + (size_t)l * W_LAYER + W_BO))[64 * nb + lane] = a;
        }
        for (int it = gw * 64 + lane; it < 4096 * 1024; it += NGW * 64) {
            const int s = it >> 10, c8 = (it & 1023) * 8, part = c8 >> 12, sp0 = c8 & 4095; float v[8];
#pragma unroll
            for (int j = 0; j < 8; ++j) { const float a = (float)((s * (sp0 + j)) & 4095) * (1.0f / 4096.0f); v[j] = (part ? -__builtin_amdgcn_sinf(a) : __builtin_amdgcn_cosf(a)) * 0.015625f; }
            u32x4 o; o.x = pk2(v[0], v[1]); o.y = pk2(v[2], v[3]); o.z = pk2(v[4], v[5]); o.w = pk2(v[6], v[7]);
            *(u32x4*)(DMAT + (size_t)s * 8192 + c8) = o;
        }
        for (int m = gw; m < MTOK; m += NGW) ln_row(x + (size_t)m * DM, ln_in_g, ln_in_b, H + (size_t)m * DM, XN + (size_t)m * DM, lane);
    }

#ifdef BENCH_KIND
    {
        float a[16];
#pragma unroll
        for (int k = 0; k < 16; ++k) a[k] = 0.001f * (float)(threadIdx.x + k);
#pragma unroll 1
        for (int it = 0; it < 8192; ++it) {
#pragma unroll
            for (int k = 0; k < 16; ++k) {
#if BENCH_KIND == 1
                asm volatile("v_fma_f32 %0, %0, %1, %2" : "+v"(a[k]) : "v"(0.999f), "v"(0.0005f));
#else
                asm volatile("v_exp_f32 %0, %0" : "+v"(a[k]));
#endif
            }
        }
        float t = 0.f;
#pragma unroll
        for (int k = 0; k < 16; ++k) t += a[k];
        if (t == 12345.678f) ((float*)(ws + WS_CTL))[8192 + threadIdx.x] = t;
    }
#endif
    GRID_SYNC_CG();

#pragma unroll 1
    for (int l = 0; l < DEPTH; ++l) {
        unsigned char* wl = ws + WS_W + (size_t)l * W_LAYER;
        const bf16_t* Wqkv_t = (const bf16_t*)(wl + W_QKV); const bf16_t* Wu_t = (const bf16_t*)(wl + W_U); const bf16_t* Wo_t = (const bf16_t*)(wl + W_O);
        const bf16_t* Wgu_t = (const bf16_t*)(wl + W_GU); const bf16_t* Wd_t = (const bf16_t*)(wl + W_D); const float* bias_o = (const float*)(wl + W_BO);
        PH(1) REP(1) { pg8::Gemm g{XN, Wqkv_t, MTOK, NQKV, DM}; pg8::StaticOrder S; S.init(MTOK, NQKV, G, bx);
          pg8::EpiQKV E{QKV, (unsigned*)(ws + WS_CTL) + CW_KMAX + l * 64};
          pg8::gemm_phase<pg8::EpiQKV, pg8::StaticOrder, true, true>(lds, g, S, E); }
        PH(2) REP(2) { pg8::Gemm g{Wu_t, XN, NU2, MTOK, DM}; pg8::StaticOrder S; S.init(NU2, MTOK, G, bx);
          pg8::EpiBf16 E{XT, SEQ, SEQ, (size_t)NU2 * SEQ};
          pg8::gemm_phase<pg8::EpiBf16, pg8::StaticOrder, true, true>(lds, g, S, E); }
        GRID_SYNC();
        PH(3) REP(3) {
            const float* lp = lam_params + l * 128; float d01 = 0.f, d23 = 0.f;
            for (int i = 0; i < 32; ++i) { d01 += lp[i] * lp[32 + i]; d23 += lp[64 + i] * lp[96 + i]; }
            const float lam_init = 0.8f - 0.6f * expf(-0.3f * (float)l);
            const float lam = expf(d01) - expf(d23) + lam_init;
            const unsigned* kmaxl = (const unsigned*)(ws + WS_CTL) + CW_KMAX + l * 64;
            if (G == 256) {
                for (int i = 0; i < 4; ++i) { const int hs = (vcu >> 4) & 1; const int hh = hs ? (i == 0 ? 1 : i == 1 ? 6 : i == 2 ? 2 : 5) : (i == 0 ? 0 : i == 1 ? 7 : i == 2 ? 3 : 4);
                    const int qq = (i & 1) ? 15 - (vcu & 15) : (vcu & 15);
                    attn_unit<0>(vcu >> 5, hh, qq, QKV, AF, lam, 1.0f - lam_init, subln_g + l * 64, kmaxl, lds); }
            } else {
                for (int u = vcu; u < BATCH * NHEAD * 16; u += G) attn_unit<0>(u >> 7, (u >> 4) & 7, u & 15, QKV, AF, lam, 1.0f - lam_init, subln_g + l * 64, kmaxl, lds);
            }
        }
        PH(4) REP(4) { pg8::Gemm g{DMAT, XT, SEQ, BATCH * 512, 2 * SEQ}; pg8::StaticOrder S; S.init(SEQ, BATCH * 512, G, bx);
          pg8::EpiDft E{AF};
          pg8::gemm_phase<pg8::EpiDft, pg8::StaticOrder, true, true>(lds, g, S, E); }
        GRID_SYNC();
        PH(5) REP(5) { pg8::Gemm g{AF, Wo_t, MTOK, DM, DM}; pg8::StaticOrder S; S.init(MTOK, DM, G, bx);
          pg8::EpiPre E{H, PRE, bias_o, ALPHA};
          pg8::gemm_phase<pg8::EpiPre, pg8::StaticOrder, true, true>(lds, g, S, E); }
        GRID_SYNC();
        PH(6) REP(6) { LANE_VARS for (int m = gw; m < MTOK; m += NGW) ln_row(PRE + (size_t)m * DM, ln1_g + l * DM, ln1_b + l * DM, H + (size_t)m * DM, XN + (size_t)m * DM, lane); }
        GRID_SYNC();
        PH(7) REP(7) { pg8::Gemm g{XN, Wgu_t, MTOK, NGU, DM}; pg8::StaticOrder S; S.init(MTOK, NGU, G, bx);
          pg8::EpiSwiGLU E{ACT, FF};
          pg8::gemm_phase<pg8::EpiSwiGLU, pg8::StaticOrder, true, true>(lds, g, S, E); }
        GRID_SYNC();
        PH(8) REP(8) { pg8::Gemm g{ACT, Wd_t, MTOK, DM, FF}; pg8::StaticOrder S; S.init(MTOK, DM, G, bx);
          pg8::EpiPre E{H, PRE, nullptr, ALPHA};
          pg8::gemm_phase<pg8::EpiPre, pg8::StaticOrder, true, true>(lds, g, S, E); }
        GRID_SYNC();
        PH(9) { LANE_VARS const bool last = (l == DEPTH - 1);
          for (int m = gw; m < MTOK; m += NGW) ln_row(PRE + (size_t)m * DM, ln2_g + l * DM, ln2_b + l * DM, last ? PRE + (size_t)m * DM : H + (size_t)m * DM, XN + (size_t)m * DM, lane); }
        if (l + 1 < DEPTH) GRID_SYNC();
    }
}

constexpr int LDS_BYTES = 147456;
extern "C" void kernel_launch(void* const* d_in, const int* in_sizes, int n_in, void* d_out, int out_size, void* d_ws, size_t ws_size, hipStream_t stream) {
    static int grid = 0;
    if (grid == 0) {
        if (n_in != 15 || out_size != MTOK * DM || ws_size < WS_END) { fprintf(stderr, "kernel_launch: unexpected problem (n_in %d, out %d, ws %zu)\n", n_in, out_size, ws_size); grid = -1; return; }
        int dev = 0, cus = 0, per_cu = 0;
        hipGetDevice(&dev); hipDeviceGetAttribute(&cus, hipDeviceAttributeMultiprocessorCount, dev);
        hipFuncSetAttribute((const void*)fwd_megakernel, hipFuncAttributeMaxDynamicSharedMemorySize, LDS_BYTES);
        hipOccupancyMaxActiveBlocksPerMultiprocessor(&per_cu, (const void*)fwd_megakernel, NTHREADS, LDS_BYTES);
        if (per_cu < 1) { fprintf(stderr, "kernel_launch: occupancy query says %d blocks per CU\n", per_cu); grid = -1; return; }
        grid = cus;
        (void)hipGetLastError();
    }
    if (grid < 0) return;
    if (hipMemsetAsync((char*)d_ws + WS_CTL, 0, 65536, stream) != hipSuccess) { fprintf(stderr, "kernel_launch: memset failed\n"); return; }
    Args a{};
    for (int i = 0; i < 15; ++i) a.in[i] = (const float*)d_in[i];
    a.out = (float*)d_out; a.ws = (unsigned char*)d_ws;
    void* kargs[] = {&a};
    hipError_t e = hipLaunchCooperativeKernel((const void*)fwd_megakernel, dim3(grid), dim3(NTHREADS), kargs, LDS_BYTES, stream);
    if (e != hipSuccess) fprintf(stderr, "cooperative launch failed: %s (grid %d)\n", hipGetErrorString(e), grid);
}
```

```cpp
#include <hip/hip_runtime.h>
#include <hip/hip_cooperative_groups.h>
#include <cstdio>
#include <cstdint>
namespace cg = cooperative_groups;
namespace pg8 {
#define PG8_LAS __attribute__((address_space(3)))
typedef unsigned short bf16_t;
typedef short bf16x8 __attribute__((ext_vector_type(8)));
typedef float f32x4 __attribute__((ext_vector_type(4)));
typedef unsigned u32x4 __attribute__((ext_vector_type(4)));
constexpr int BM = 256, BK = 64, HALF = 128, HTB = HALF * BK * 2  , STAGE_BYTES = 8 * HTB, NXCD = 8, WGM = 8;

__host__ __device__ __forceinline__ int lds_byte(int r, int c) { const int st = (r >> 4) * 2 + (c >> 5), rr = r & 15, cc = c & 31, ob = rr * 64 + cc * 2; return st * 1024 + (ob ^ (((ob >> 9) & 1) << 5)); }
__host__ __device__ __forceinline__ void stage_rc(int b, int& R, int& C) { const int st = b / 1024, sb = b % 1024, swz = sb ^ (((sb >> 9) & 1) << 5); R = (st >> 1) * 16 + swz / 64; C = (st & 1) * 32 + (swz % 64) / 2; }
__host__ __device__ __forceinline__ int perm32(int rho) { const int n = rho >> 4, i = rho & 15; return 8 * (i >> 2) + 4 * n + (i & 3); }

struct Unit { int pm, pn; };
struct Gemm { const bf16_t* A; const bf16_t* Bt; int M, N, K; };

struct StaticOrder {
    int nM, nN, nwg, G, c;
    __host__ __device__ void init(int M, int N, int G_, int c_) { nM = M / BM; nN = N / BM; nwg = nM * nN; G = G_; c = c_; }
    __host__ __device__ bool next(int i, Unit& u) const {
        const long L = (long)i * G + c; if (L >= nwg) return false;
        int wgid = (int)L; { const int q = nwg / NXCD, r = nwg % NXCD, xcd = wgid % NXCD, off = wgid / NXCD; wgid = (xcd < r ? xcd * (q + 1) : r * (q + 1) + (xcd - r) * q) + off; }
        const int nig = WGM * nN, gid = wgid / nig, fm = gid * WGM, gsz = (nM - fm) < WGM ? (nM - fm) : WGM;
        u.pm = fm + ((wgid % nig) % gsz); u.pn = (wgid % nig) / gsz; return true;
    }
    __device__ __forceinline__ void a_ready(const Unit&) const {}
    __device__ __forceinline__ void done(const Unit&) const {}
};

__device__ __forceinline__ unsigned cvt_pk_bf16(float lo, float hi) { unsigned r; asm volatile("v_cvt_pk_bf16_f32 %0, %1, %2" : "=v"(r) : "v"(lo), "v"(hi)); return r; }
typedef float f32x2 __attribute__((ext_vector_type(2)));

struct EpiBf16 {
    static constexpr bool PERM = true, AFTER_DRAIN = false;
    bf16_t* O; int ldc; int split_cols; size_t split_stride;
    __device__ __forceinline__ void operator()(const f32x4 (&acc)[2][2][4][2], const Unit& u, int wr, int wc, int fr, int fq) const {
        const int row0 = u.pm * BM + wr * 64 + fr; int colt = u.pn * BM; bf16_t* base = O;
        if (split_cols) { const int t = colt / split_cols; base += (size_t)t * split_stride; colt -= t * split_cols; }
        const int col0 = colt + wc * 32 + 8 * fq;
#pragma unroll
        for (int ai = 0; ai < 2; ++ai)
#pragma unroll
            for (int m = 0; m < 4; ++m) { bf16_t* rowp = base + (size_t)(row0 + ai * HALF + m * 16) * ldc + col0;
#pragma unroll
                for (int bj = 0; bj < 2; ++bj) { const f32x4 v0 = acc[ai][bj][m][0], v1 = acc[ai][bj][m][1];
                    u32x4 w; w.x = cvt_pk_bf16(v0[0], v0[1]); w.y = cvt_pk_bf16(v0[2], v0[3]); w.z = cvt_pk_bf16(v1[0], v1[1]); w.w = cvt_pk_bf16(v1[2], v1[3]);
                    *(u32x4*)(rowp + bj * HALF) = w; } }
    }
};
struct EpiQKV {
    static constexpr bool PERM = true, AFTER_DRAIN = false;
    bf16_t* O; unsigned* kmax;
    __device__ __forceinline__ void operator()(const f32x4 (&acc)[2][2][4][2], const Unit& u, int wr, int wc, int fr, int fq) const {
        const int row0 = u.pm * BM + wr * 64 + fr; const int col0 = u.pn * BM + wc * 32 + 8 * fq;
        const bool isk = (u.pn == 2 || u.pn == 3);
        float kn[2] = {0.f, 0.f};
#pragma unroll
        for (int ai = 0; ai < 2; ++ai)
#pragma unroll
            for (int m = 0; m < 4; ++m) { bf16_t* rowp = O + (size_t)(row0 + ai * HALF + m * 16) * 1536 + col0;
#pragma unroll
                for (int bj = 0; bj < 2; ++bj) { const f32x4 v0 = acc[ai][bj][m][0], v1 = acc[ai][bj][m][1];
                    u32x4 w; w.x = cvt_pk_bf16(v0[0], v0[1]); w.y = cvt_pk_bf16(v0[2], v0[3]); w.z = cvt_pk_bf16(v1[0], v1[1]); w.w = cvt_pk_bf16(v1[2], v1[3]);
                    *(u32x4*)(rowp + bj * HALF) = w;
                    if (isk) { float ss = (v0[0] * v0[0] + v0[1] * v0[1]) + (v0[2] * v0[2] + v0[3] * v0[3]) + (v1[0] * v1[0] + v1[1] * v1[1]) + (v1[2] * v1[2] + v1[3] * v1[3]);
                        ss += __shfl_xor(ss, 16); ss += __shfl_xor(ss, 32); kn[bj] = __builtin_fmaxf(kn[bj], ss); } } }
        if (isk) {
#pragma unroll
            for (int bj = 0; bj < 2; ++bj) { float v = kn[bj];
                v = __builtin_fmaxf(v, __shfl_xor(v, 1)); v = __builtin_fmaxf(v, __shfl_xor(v, 2)); v = __builtin_fmaxf(v, __shfl_xor(v, 4)); v = __builtin_fmaxf(v, __shfl_xor(v, 8));
                if (fr == 0 && fq == 0) atomicMax(kmax + (u.pm >> 4) * 8 + 4 * (u.pn - 2) + 2 * bj + (wc >> 1), __builtin_bit_cast(unsigned, v)); }
        }
    }
};
struct EpiDft {
    static constexpr bool PERM = true, AFTER_DRAIN = false;
    bf16_t* O;
    __device__ __forceinline__ void operator()(const f32x4 (&acc)[2][2][4][2], const Unit& u, int wr, int wc, int fr, int fq) const {
        const int row0 = (u.pn >> 1) * 4096 + u.pm * BM + wr * 64 + fr; const int col0 = 512 + (u.pn & 1) * 256 + wc * 32 + 8 * fq;
#pragma unroll
        for (int ai = 0; ai < 2; ++ai)
#pragma unroll
            for (int m = 0; m < 4; ++m) { bf16_t* rowp = O + (size_t)(row0 + ai * HALF + m * 16) * 1024 + col0;
#pragma unroll
                for (int bj = 0; bj < 2; ++bj) { const f32x4 v0 = acc[ai][bj][m][0], v1 = acc[ai][bj][m][1];
                    u32x4 w; w.x = cvt_pk_bf16(v0[0], v0[1]); w.y = cvt_pk_bf16(v0[2], v0[3]); w.z = cvt_pk_bf16(v1[0], v1[1]); w.w = cvt_pk_bf16(v1[2], v1[3]);
                    *(u32x4*)(rowp + bj * HALF) = w; } }
    }
};
struct EpiSwiGLU {
    static constexpr bool PERM = true, AFTER_DRAIN = false;
    bf16_t* O; int ldc;
    __device__ __forceinline__ static float sw(float g, float up) { const float e = __builtin_amdgcn_exp2f(g * -1.4426950408889634f); return g * up * __builtin_amdgcn_rcpf(1.0f + e); }
    __device__ __forceinline__ void operator()(const f32x4 (&acc)[2][2][4][2], const Unit& u, int wr, int wc, int fr, int fq) const {
        const int row0 = u.pm * BM + wr * 64 + fr; const int col0 = u.pn * HALF + wc * 32 + 8 * fq;
#pragma unroll
        for (int ai = 0; ai < 2; ++ai)
#pragma unroll
            for (int m = 0; m < 4; ++m) { bf16_t* rowp = O + (size_t)(row0 + ai * HALF + m * 16) * ldc + col0;
                const f32x4 g0 = acc[ai][0][m][0], g1 = acc[ai][0][m][1], u0 = acc[ai][1][m][0], u1 = acc[ai][1][m][1];
                u32x4 w; w.x = cvt_pk_bf16(sw(g0[0], u0[0]), sw(g0[1], u0[1])); w.y = cvt_pk_bf16(sw(g0[2], u0[2]), sw(g0[3], u0[3]));
                w.z = cvt_pk_bf16(sw(g1[0], u1[0]), sw(g1[1], u1[1])); w.w = cvt_pk_bf16(sw(g1[2], u1[2]), sw(g1[3], u1[3]));
                *(u32x4*)rowp = w; }
    }
};
struct EpiPre {
    static constexpr bool PERM = false, AFTER_DRAIN = false;
    const float* H; float* PRE; const float* bias; float alpha;
    __device__ __forceinline__ void operator()(const f32x4 (&acc)[2][2][4][2], const Unit& u, int wr, int wc, int fr, int fq) const {
        const int col0 = u.pn * BM + wc * 32 + 4 * fq;
#pragma unroll
        for (int ai = 0; ai < 2; ++ai)
#pragma unroll
            for (int m = 0; m < 4; ++m) { const size_t off = (size_t)(u.pm * BM + ai * HALF + wr * 64 + m * 16 + fr) * 1024 + col0;
#pragma unroll
                for (int bj = 0; bj < 2; ++bj)
#pragma unroll
                    for (int n = 0; n < 2; ++n) { const int cc = bj * HALF + n * 16;
                        const f32x4 hb = *(const f32x4*)(H + off + cc); f32x4 o = hb * alpha + acc[ai][bj][m][n];
                        if (bias) o += *(const f32x4*)(bias + col0 + cc);
                        *(f32x4*)(PRE + off + cc) = o; } }
    }
};
template <class Epi, class Sched, bool ALIGN_EPI = false, bool SP2 = false>
__device__ __forceinline__ void gemm_phase(PG8_LAS unsigned char* lds, const Gemm g, const Sched& S, const Epi& E, const int wave_id) {
    int lane_ = __builtin_amdgcn_mbcnt_hi(~0u, __builtin_amdgcn_mbcnt_lo(~0u, 0u)); asm volatile("" : "+v"(lane_));
    const int wid = wave_id, lane = lane_, tid = wid * 64 + lane, wr = wid >> 2, wc = wid & 3, fr = lane & 15, fq = lane >> 4;
    const int K = g.K, nt = K / BK;
    unsigned voffA[2], voffB[2];
#pragma unroll
    for (int i = 0; i < 2; ++i) { int R, C; stage_rc(tid * 16 + i * 8192, R, C); const int Rb = Epi::PERM ? ((R & ~31) + perm32(R & 31)) : R;
        voffA[i] = (unsigned)(R * K + C) * 2u; voffB[i] = (unsigned)(Rb * K + C) * 2u; }
    const size_t kstep = (size_t)(BK * 2);
    const size_t hstep = (size_t)HALF * K * 2;
    const size_t tstep = 2 * hstep;
    const unsigned ldsw = (unsigned)wid * 1024u;
    const int aoff = lds_byte(wr * 64 + fr, fq * 8), boff = lds_byte(wc * 32 + fr, fq * 8);
#define PG8_SA(b, h) (((b) * 2 + (h)) * HTB)
#define PG8_SB(b, h) ((4 + (b) * 2 + (h)) * HTB)
#define PG8_STAGE(bufoff, gbase, voff) do { _Pragma("unroll") for (int _i = 0; _i < 2; ++_i) \
        __builtin_amdgcn_global_load_lds((const unsigned*)((const char*)(gbase) + (voff)[_i]), (PG8_LAS unsigned*)(lds + (bufoff) + ldsw + _i * 8192), 16, 0, 0); } while (0)
#define PG8_LDA(dst, b, h) do { _Pragma("unroll") for (int m = 0; m < 4; ++m) _Pragma("unroll") for (int k = 0; k < 2; ++k) dst[m][k] = *(const PG8_LAS bf16x8*)(lds + PG8_SA(b, h) + aoff + m * 2048 + k * 1024); } while (0)
#define PG8_LDB(dst, b, h) do { _Pragma("unroll") for (int n = 0; n < 2; ++n) _Pragma("unroll") for (int k = 0; k < 2; ++k) dst[n][k] = *(const PG8_LAS bf16x8*)(lds + PG8_SB(b, h) + boff + n * 2048 + k * 1024); } while (0)
#define PG8_MMA(ai, bj, At, Bt) do { __builtin_amdgcn_s_setprio(1); _Pragma("unroll") for (int m = 0; m < 4; ++m) _Pragma("unroll") for (int n = 0; n < 2; ++n) _Pragma("unroll") for (int k = 0; k < 2; ++k) \
        acc[ai][bj][m][n] = __builtin_amdgcn_mfma_f32_16x16x32_bf16(Bt[n][k], At[m][k], acc[ai][bj][m][n], 0, 0, 0); __builtin_amdgcn_s_setprio(0); } while (0)
#define PG8_WAIT_V(n) asm volatile("s_waitcnt vmcnt(" #n ")" ::: "memory")
#define PG8_WAIT_L(n) asm volatile("s_waitcnt lgkmcnt(" #n ")" ::: "memory")
#define PG8_BAR __builtin_amdgcn_s_barrier()
#define PG8_SCHED __builtin_amdgcn_sched_barrier(0)
    Unit cur, nxt; int ui = 0;
    if (!S.next(0, cur)) return;
    f32x4 acc[2][2][4][2];
#pragma unroll
    for (int a = 0; a < 2; ++a)
#pragma unroll
        for (int b = 0; b < 2; ++b)
#pragma unroll
            for (int m = 0; m < 4; ++m)
#pragma unroll
                for (int n = 0; n < 2; ++n) acc[a][b][m][n] = (f32x4){0.f, 0.f, 0.f, 0.f};
    bf16x8 At[4][2], B0[2][2], B1[2][2];
    const char* cA = (const char*)g.A + (size_t)cur.pm * tstep; const char* cB = (const char*)g.Bt + (size_t)cur.pn * tstep;
    S.a_ready(cur);
    if constexpr (SP2) {
        PG8_STAGE(PG8_SB(0, 0), cB, voffB); PG8_STAGE(PG8_SB(0, 1), cB + hstep, voffB); PG8_STAGE(PG8_SA(0, 0), cA, voffA); PG8_STAGE(PG8_SA(0, 1), cA + hstep, voffA);
        if (wr == 1) PG8_BAR;
        PG8_WAIT_V(2); PG8_BAR;
        PG8_STAGE(PG8_SB(1, 0), cB + kstep, voffB); PG8_STAGE(PG8_SA(1, 0), cA + kstep, voffA); PG8_STAGE(PG8_SB(1, 1), cB + hstep + kstep, voffB);
        PG8_WAIT_V(6); PG8_BAR;
    } else {
        PG8_STAGE(PG8_SB(0, 0), cB, voffB); PG8_STAGE(PG8_SA(0, 0), cA, voffA); PG8_STAGE(PG8_SB(0, 1), cB + hstep, voffB); PG8_STAGE(PG8_SA(0, 1), cA + hstep, voffA);
        if (wr == 1) PG8_BAR;
        PG8_WAIT_V(4); PG8_BAR;
        PG8_STAGE(PG8_SB(1, 0), cB + kstep, voffB); PG8_STAGE(PG8_SA(1, 0), cA + kstep, voffA); PG8_STAGE(PG8_SB(1, 1), cB + hstep + kstep, voffB);
        PG8_WAIT_V(6); PG8_BAR;
    }
    for (;;) {
        const bool has_next = S.next(ui + 1, nxt);
        const char* nA = has_next ? (const char*)g.A + (size_t)nxt.pm * tstep : cA; const char* nB = has_next ? (const char*)g.Bt + (size_t)nxt.pn * tstep : cB;
        for (int t = 0; t < nt; t += 2) {
            const bool last = (t == nt - 2);
            const char* a1 = cA + (size_t)(t + 1) * kstep;
            const char* a2 = last ? nA : cA + (size_t)(t + 2) * kstep; const char* b2 = last ? nB : cB + (size_t)(t + 2) * kstep;
            const char* a3 = a2 + kstep; const char* b3 = b2 + kstep;
            if (last && has_next) S.a_ready(nxt);
            if constexpr (SP2) {
            PG8_LDB(B0, 0, 0); PG8_LDB(B1, 0, 1); PG8_SCHED; PG8_LDA(At, 0, 0); PG8_STAGE(PG8_SA(1, 1), a1 + hstep, voffA);
            PG8_WAIT_V(8); PG8_WAIT_L(0); PG8_BAR; PG8_MMA(0, 0, At, B0); PG8_MMA(0, 1, At, B1); PG8_BAR; PG8_SCHED;
            PG8_LDA(At, 0, 1); PG8_STAGE(PG8_SB(0, 0), b2, voffB); PG8_STAGE(PG8_SB(0, 1), b2 + hstep, voffB); PG8_STAGE(PG8_SA(0, 0), a2, voffA);
            PG8_WAIT_V(8); PG8_WAIT_L(0); PG8_BAR; PG8_MMA(1, 0, At, B0); PG8_MMA(1, 1, At, B1); PG8_BAR; PG8_SCHED;
            PG8_LDB(B0, 1, 0); PG8_LDB(B1, 1, 1); PG8_SCHED; PG8_LDA(At, 1, 0); PG8_STAGE(PG8_SA(0, 1), a2 + hstep, voffA);
            PG8_WAIT_V(8); PG8_WAIT_L(0); PG8_BAR; PG8_MMA(0, 0, At, B0); PG8_MMA(0, 1, At, B1); PG8_BAR; PG8_SCHED;
            PG8_LDA(At, 1, 1); PG8_STAGE(PG8_SB(1, 0), b3, voffB); PG8_STAGE(PG8_SB(1, 1), b3 + hstep, voffB); PG8_STAGE(PG8_SA(1, 0), a3, voffA);
            PG8_WAIT_V(8); PG8_WAIT_L(0); PG8_BAR; PG8_MMA(1, 0, At, B0); PG8_MMA(1, 1, At, B1); PG8_BAR; PG8_SCHED;
            } else {
            PG8_LDB(B0, 0, 0); PG8_SCHED; PG8_LDA(At, 0, 0); PG8_STAGE(PG8_SA(1, 1), a1 + hstep, voffA);
            PG8_WAIT_L(8); PG8_BAR; PG8_WAIT_L(0); PG8_MMA(0, 0, At, B0); PG8_BAR; PG8_SCHED;
            PG8_LDB(B1, 0, 1); PG8_STAGE(PG8_SB(0, 0), b2, voffB);
            PG8_BAR; PG8_WAIT_L(0); PG8_MMA(0, 1, At, B1); PG8_BAR;
            PG8_LDA(At, 0, 1); PG8_STAGE(PG8_SA(0, 0), a2, voffA);
            PG8_BAR; PG8_WAIT_L(0); PG8_MMA(1, 0, At, B0); PG8_BAR; PG8_SCHED;
            PG8_STAGE(PG8_SB(0, 1), b2 + hstep, voffB);
            PG8_WAIT_V(6); PG8_BAR; PG8_MMA(1, 1, At, B1); PG8_BAR;
            PG8_LDB(B0, 1, 0); PG8_SCHED; PG8_LDA(At, 1, 0); PG8_STAGE(PG8_SA(0, 1), a2 + hstep, voffA);
            PG8_WAIT_L(8); PG8_BAR; PG8_WAIT_L(0); PG8_MMA(0, 0, At, B0); PG8_BAR; PG8_SCHED;
            PG8_LDB(B1, 1, 1); PG8_STAGE(PG8_SB(1, 0), b3, voffB);
            PG8_BAR; PG8_WAIT_L(0); PG8_MMA(0, 1, At, B1); PG8_BAR;
            PG8_LDA(At, 1, 1); PG8_STAGE(PG8_SA(1, 0), a3, voffA);
            PG8_BAR; PG8_WAIT_L(0); PG8_MMA(1, 0, At, B0); PG8_BAR; PG8_SCHED;
            PG8_STAGE(PG8_SB(1, 1), b3 + hstep, voffB);
            PG8_WAIT_V(6); PG8_BAR; PG8_MMA(1, 1, At, B1); PG8_BAR;
            }
        }
        if constexpr (ALIGN_EPI) { if (wr == 0) PG8_BAR; }
        if constexpr (!Epi::AFTER_DRAIN) { E(acc, cur, wr, wc, fr, fq); S.done(cur); }
        if (!has_next) break;
#pragma unroll
        for (int a = 0; a < 2; ++a)
#pragma unroll
            for (int b = 0; b < 2; ++b)
#pragma unroll
                for (int m = 0; m < 4; ++m)
#pragma unroll
                    for (int n = 0; n < 2; ++n) acc[a][b][m][n] = (f32x4){0.f, 0.f, 0.f, 0.f};
        cur = nxt; cA = nA; cB = nB; ++ui;
        if constexpr (ALIGN_EPI) { if (wr == 1) PG8_BAR; }
    }
    PG8_WAIT_V(0);
    if constexpr (!ALIGN_EPI) { if (wr == 0) PG8_BAR; }
    PG8_BAR;
    if constexpr (Epi::AFTER_DRAIN) { E.fused(acc, cur, wr, wc, fr, fq, lds, wid, lane); S.done(cur); }
#undef PG8_SA
#undef PG8_SB
#undef PG8_STAGE
#undef PG8_LDA
#undef PG8_LDB
#undef PG8_MMA
#undef PG8_WAIT_V
#undef PG8_WAIT_L
#undef PG8_BAR
#undef PG8_SCHED
}
}
constexpr int BATCH = 8, SEQ = 4096, DM = 1024, DEPTH = 2, MTOK = BATCH * SEQ;
constexpr int NQKV = 1536, NU2 = 1024, FF = 2816, NGU = 2 * FF, NHEAD = 8;
constexpr float LN_EPS = 1e-5f, SUBLN_EPS = 1e-5f;
constexpr float ALPHA = 1.4142135623730951f;
constexpr float QSCALE = 0.17677669529663687f * 1.4426950408889634f;
constexpr int NWAVES = 8, NTHREADS = 512;

typedef unsigned short bf16_t;
typedef short bf16x8 __attribute__((ext_vector_type(8)));
typedef short s16x4 __attribute__((ext_vector_type(4)));
typedef float f32x4 __attribute__((ext_vector_type(4)));
typedef float f32x16 __attribute__((ext_vector_type(16)));
typedef unsigned u32x4 __attribute__((ext_vector_type(4)));
typedef unsigned u32x2 __attribute__((ext_vector_type(2)));
#define LAS __attribute__((address_space(3)))

constexpr size_t MiB = 1u << 20;
constexpr size_t WS_CTL = 0;
constexpr size_t WS_W = 2 * MiB, W_LAYER = 24 * MiB;
constexpr size_t W_QKV = 0, W_U = 3 * MiB, W_O = 5 * MiB, W_GU = 7 * MiB, W_D = 18 * MiB, W_BO = 23 * MiB + 512 * 1024;
constexpr size_t WS_DMAT = 50 * MiB;
constexpr size_t WS_XN = 114 * MiB;
constexpr size_t WS_H = 178 * MiB;
constexpr size_t WS_QKV = 306 * MiB;
constexpr size_t WS_XT = 402 * MiB;
constexpr size_t WS_ACT = 306 * MiB;
constexpr size_t WS_END = 482 * MiB;

struct Args { const float* in[15]; float* out; unsigned char* ws; };

__device__ __forceinline__ unsigned f2bf(float f) { unsigned u = __builtin_bit_cast(unsigned, f); return (u + 0x7fffu + ((u >> 16) & 1u)) >> 16; }
__device__ __forceinline__ unsigned pk2(float lo, float hi) { return f2bf(lo) | (f2bf(hi) << 16); }
__device__ __forceinline__ float wave_sum(float v) {
#pragma unroll
    for (int o = 1; o < 64; o <<= 1) v += __shfl_xor(v, o);
    return v;
}

__device__ __forceinline__ void tr_item(const float* W, int ldw, bf16_t* WT, int ldt, int k0, int n0, int mode, float scale, LAS float* scr, int lane) {
#pragma unroll 8
    for (int i = 0; i < 32; ++i) { const int kk = 2 * i + (lane >> 5); scr[kk * 33 + (lane & 31)] = W[(size_t)(k0 + kk) * ldw + n0 + (lane & 31)] * scale; }
    asm volatile("s_waitcnt lgkmcnt(0)" ::: "memory");
    int r0 = n0;
    if (mode == 1) { const int part = n0 >= FF ? 1 : 0; const int ff = n0 - part * FF; r0 = (ff >> 7) * 256 + part * 128 + (ff & 127); }
    const int c = lane & 7;
#pragma unroll
    for (int j = 0; j < 4; ++j) { const int n = (lane >> 3) + 8 * j; const LAS float* s = scr + (8 * c) * 33 + n;
        u32x4 o; o.x = pk2(s[0 * 33], s[1 * 33]); o.y = pk2(s[2 * 33], s[3 * 33]); o.z = pk2(s[4 * 33], s[5 * 33]); o.w = pk2(s[6 * 33], s[7 * 33]);
        *(u32x4*)(WT + (size_t)(r0 + n) * ldt + k0 + 8 * c) = o; }
    asm volatile("s_waitcnt lgkmcnt(0)" ::: "memory");
}
__device__ __forceinline__ void ln_row(const float* src, const float* g, const float* bta, float* dstf, bf16_t* dstb, int lane) {
    const f32x4* xr = (const f32x4*)src + lane;
    f32x4 v[4]; float s = 0.f;
#pragma unroll
    for (int j = 0; j < 4; ++j) { v[j] = xr[64 * j]; s += (v[j].x + v[j].y) + (v[j].z + v[j].w); }
    const float mean = wave_sum(s) * (1.f / DM); float s2 = 0.f;
#pragma unroll
    for (int j = 0; j < 4; ++j) { v[j] = v[j] - mean; s2 += (v[j].x * v[j].x + v[j].y * v[j].y) + (v[j].z * v[j].z + v[j].w * v[j].w); }
    const float rstd = 1.f / sqrtf(wave_sum(s2) * (1.f / DM) + LN_EPS);
#pragma unroll
    for (int j = 0; j < 4; ++j) { const f32x4 gg = ((const f32x4*)g)[lane + 64 * j], bb = ((const f32x4*)bta)[lane + 64 * j];
        const f32x4 o = v[j] * rstd * gg + bb;
        if (dstf) ((f32x4*)dstf)[lane + 64 * j] = o;
        u32x2 w; w.x = pk2(o.x, o.y); w.y = pk2(o.z, o.w); ((u32x2*)dstb)[lane + 64 * j] = w; }
}

__device__ __forceinline__ int crow(int r, int hi) { return (r & 3) + 8 * (r >> 2) + 4 * hi; }
__device__ __forceinline__ bf16x8 vfrag(const LAS unsigned char* p) {
    typedef short v4s __attribute__((ext_vector_type(4)));
    const v4s lo = __builtin_amdgcn_ds_read_tr16_b64_v4i16((LAS v4s*)p), hi = __builtin_amdgcn_ds_read_tr16_b64_v4i16((LAS v4s*)(p + 512));
    return (bf16x8){lo[0], lo[1], lo[2], lo[3], hi[0], hi[1], hi[2], hi[3]};
}
__device__ __forceinline__ int attn_tile_of(int idx, int tq, int nL) { return idx < 4 ? tq + idx : (idx < 4 + nL ? tq + 3 - idx : tq + idx - nL); }
constexpr float ATT_SKIP_T = 32.0f;
constexpr float ATT_THR = 16.0f;
constexpr int ATT_TILE = 16384;
constexpr int ATT_QOFF = 3 * ATT_TILE;
__device__ __forceinline__ void attn_qk(f32x16 (&s)[2], const LAS unsigned char* tl, const LAS unsigned char* ql, int kof0, const f32x16& cb0, bool diag, float tb, float slope2, float mref, float delta) {
    const int kof1 = kof0 ^ 32;
    const bf16x8 k00 = *(const LAS bf16x8*)(tl + kof0), k01 = *(const LAS bf16x8*)(tl + kof0 + 4096), k10 = *(const LAS bf16x8*)(tl + kof1), k11 = *(const LAS bf16x8*)(tl + kof1 + 4096);
    const bf16x8 q0 = *(const LAS bf16x8*)(ql + kof0), q1 = *(const LAS bf16x8*)(ql + kof1);
    f32x16 c1;
    if (diag) {
#pragma unroll
        for (int r = 0; r < 16; ++r) c1[r] = -slope2 * __builtin_fabsf(tb + (float)(32 + (r & 3) + 8 * (r >> 2))) - mref;
    } else {
#pragma unroll
        for (int r = 0; r < 16; ++r) c1[r] = cb0[r] + delta;
    }
    s[0] = __builtin_amdgcn_mfma_f32_32x32x16_bf16(k00, q0, cb0, 0, 0, 0); s[1] = __builtin_amdgcn_mfma_f32_32x32x16_bf16(k01, q0, c1, 0, 0, 0);
    s[0] = __builtin_amdgcn_mfma_f32_32x32x16_bf16(k10, q1, s[0], 0, 0, 0); s[1] = __builtin_amdgcn_mfma_f32_32x32x16_bf16(k11, q1, s[1], 0, 0, 0);
}
template <int VAR>
__device__ __forceinline__ void attn_softmax(f32x16 (&s)[2], u32x4 (&pf)[4], f32x16 (&so)[2], f32x16& cb0, f32x16 (&o)[2][2], float& mref, float (&lrow)[2], float& lsum, bool first) {
    if (VAR != 7) {
    float ma = __builtin_fmaxf(s[0][0], s[1][0]), mb = __builtin_fmaxf(s[0][1], s[1][1]), mc = __builtin_fmaxf(s[0][2], s[1][2]), md = __builtin_fmaxf(s[0][3], s[1][3]);
#pragma unroll
    for (int r = 4; r < 16; r += 4) { ma = __builtin_fmaxf(__builtin_fmaxf(ma, s[0][r]), s[1][r]); mb = __builtin_fmaxf(__builtin_fmaxf(mb, s[0][r + 1]), s[1][r + 1]);
        mc = __builtin_fmaxf(__builtin_fmaxf(mc, s[0][r + 2]), s[1][r + 2]); md = __builtin_fmaxf(__builtin_fmaxf(md, s[0][r + 3]), s[1][r + 3]); }
    float mx = __builtin_fmaxf(__builtin_fmaxf(ma, mb), __builtin_fmaxf(mc, md));
    mx = __builtin_fmaxf(mx, __shfl_xor(mx, 32));
    if (first || __any(mx > ATT_THR)) {
        const float dl = first ? mx : __builtin_fmaxf(mx, 0.f), f = first ? 1.0f : __builtin_amdgcn_exp2f(-dl);
        mref += dl; lrow[0] *= f; lrow[1] *= f;
#pragma unroll
        for (int r = 0; r < 16; ++r) { s[0][r] -= dl; s[1][r] -= dl; cb0[r] -= dl; so[0][r] -= dl; so[1][r] -= dl;
            o[0][0][r] *= f; o[0][1][r] *= f; o[1][0][r] *= f; o[1][1][r] *= f; }
    }
    float ra = 0.f, rb = 0.f;
#pragma unroll
    for (int r = 0; r < 16; ++r) { if (VAR == 3) { s[0][r] = s[0][r] * 0.5f; s[1][r] = s[1][r] * 0.5f; } else { s[0][r] = __builtin_amdgcn_exp2f(s[0][r]); s[1][r] = __builtin_amdgcn_exp2f(s[1][r]); } ra += s[0][r]; rb += s[1][r]; }
    lsum += ra + rb;
    }
    pf[0] = (u32x4){pg8::cvt_pk_bf16(s[0][0], s[0][1]), pg8::cvt_pk_bf16(s[0][2], s[0][3]), pg8::cvt_pk_bf16(s[0][4], s[0][5]), pg8::cvt_pk_bf16(s[0][6], s[0][7])};
    pf[1] = (u32x4){pg8::cvt_pk_bf16(s[0][8], s[0][9]), pg8::cvt_pk_bf16(s[0][10], s[0][11]), pg8::cvt_pk_bf16(s[0][12], s[0][13]), pg8::cvt_pk_bf16(s[0][14], s[0][15])};
    pf[2] = (u32x4){pg8::cvt_pk_bf16(s[1][0], s[1][1]), pg8::cvt_pk_bf16(s[1][2], s[1][3]), pg8::cvt_pk_bf16(s[1][4], s[1][5]), pg8::cvt_pk_bf16(s[1][6], s[1][7])};
    pf[3] = (u32x4){pg8::cvt_pk_bf16(s[1][8], s[1][9]), pg8::cvt_pk_bf16(s[1][10], s[1][11]), pg8::cvt_pk_bf16(s[1][12], s[1][13]), pg8::cvt_pk_bf16(s[1][14], s[1][15])};
}
#define ATT_VTR(dst, addr, off) asm volatile("ds_read_b64_tr_b16 %0, %1 offset:%2" : "=v"(dst) : "v"(addr), "i"(off))
__device__ __forceinline__ void attn_vload(s16x4 (&vlo)[8], s16x4 (&vhi)[8], unsigned va) {
    ATT_VTR(vlo[0], va, 0);    ATT_VTR(vhi[0], va, 512);  ATT_VTR(vlo[1], va, 1024); ATT_VTR(vhi[1], va, 1536);
    ATT_VTR(vlo[2], va, 2048); ATT_VTR(vhi[2], va, 2560); ATT_VTR(vlo[3], va, 3072); ATT_VTR(vhi[3], va, 3584);
    ATT_VTR(vlo[4], va, 4096); ATT_VTR(vhi[4], va, 4608); ATT_VTR(vlo[5], va, 5120); ATT_VTR(vhi[5], va, 5632);
    ATT_VTR(vlo[6], va, 6144); ATT_VTR(vhi[6], va, 6656); ATT_VTR(vlo[7], va, 7168); ATT_VTR(vhi[7], va, 7680);
}
__device__ __forceinline__ void attn_pv(f32x16 (&oc)[2], const u32x4 (&pf)[4], const s16x4 (&vlo)[8], const s16x4 (&vhi)[8]) {
#pragma unroll
    for (int d = 0; d < 2; ++d)
#pragma unroll
        for (int s4 = 0; s4 < 4; ++s4) { const s16x4 a = vlo[d * 4 + s4], b = vhi[d * 4 + s4]; const bf16x8 vf = (bf16x8){a[0], a[1], a[2], a[3], b[0], b[1], b[2], b[3]};
            oc[d] = __builtin_amdgcn_mfma_f32_32x32x16_bf16(vf, __builtin_bit_cast(bf16x8, pf[s4]), oc[d], 0, 0, 0); }
}
template <int VAR>
__device__ __forceinline__ void attn_unit(int b, int h, int qb, const bf16_t* QKV, bf16_t* AF, float lam, float oscale, const float* subg, const unsigned* kmax, LAS unsigned char* lds, const int wave_id) {
    int lane_ = __builtin_amdgcn_mbcnt_hi(~0u, __builtin_amdgcn_mbcnt_lo(~0u, 0u)); asm volatile("" : "+v"(lane_));
    const int wid = wave_id, lane = lane_, tid = wid * 64 + lane, r32 = lane & 31, hi = lane >> 5;
    const size_t rowbase = (size_t)b * SEQ; const int q0 = qb * 256 + wid * 32, tq = qb * 4;
    const float slope2 = __uint_as_float(__builtin_amdgcn_readfirstlane(__float_as_uint(__builtin_amdgcn_exp2f(-(float)(h + 1)) * 1.4426950408889634f)));
    const int kkey = 8 * wid + (lane >> 3);
    const unsigned kvo = (unsigned)(kkey * NQKV + 512 + h * 64 + (((lane & 7) ^ ((kkey >> 1) & 7)) << 3)) * 2u;
    const unsigned vvo = (unsigned)((16 * (wid & 3) + 8 * (lane >> 5) + ((lane >> 2) & 7)) * NQKV + 1024 + h * 64 + 32 * (wid >> 2) + 8 * (lane & 3)) * 2u;
    const char* qkvb = (const char*)(QKV + rowbase * NQKV);
#define ATT_DMA_TILE(t, slot) do { const char* tb_ = qkvb + (size_t)(t) * (64 * NQKV * 2); \
        __builtin_amdgcn_global_load_lds((const unsigned*)(tb_ + kvo), (LAS unsigned*)(lds + (slot) + wid * 1024), 16, 0, 0); \
        __builtin_amdgcn_global_load_lds((const unsigned*)(tb_ + vvo), (LAS unsigned*)(lds + (slot) + 8192 + wid * 1024), 16, 0, 0); } while (0)
    { const char* qb_ = qkvb + (size_t)(qb * 256) * (NQKV * 2) - 1024;
#pragma unroll
      for (int p = 0; p < 4; ++p) __builtin_amdgcn_global_load_lds((const unsigned*)(qb_ + (size_t)p * (64 * NQKV * 2) + kvo), (LAS unsigned*)(lds + ATT_QOFF + p * 8192 + wid * 1024), 16, 0, 0); }
    ATT_DMA_TILE(tq, 0);
    const int kofA = r32 * 128 + ((hi ^ ((r32 >> 1) & 7)) << 4), kofB = kofA ^ 64;
    const LAS unsigned char* ql = lds + ATT_QOFF + wid * 4096;
    const int vrb = 8192 + ((lane >> 4) & 1) * 32 + (lane & 3) * 8 + (4 * hi + ((lane & 15) >> 2)) * 64;
    f32x16 o[2][2], cb0, sA[2], sB[2]; float mref = 0.f, lrow[2] = {0.f, 0.f};
#pragma unroll
    for (int d = 0; d < 2; ++d)
#pragma unroll
        for (int r = 0; r < 16; ++r) { o[0][d][r] = 0.f; o[1][d][r] = 0.f; }
    const float kb0 = (float)(4 * hi) - (float)(q0 + r32);
    const float step = -64.0f * slope2;
    asm volatile("s_waitcnt vmcnt(0)" ::: "memory");
    __syncthreads();
    int nL, nR;
    {
        const int qrow = tid >> 1, qc = tid & 1; float qs = 0.f;
#pragma unroll
        for (int ch = 0; ch < 4; ++ch) { const bf16x8 v = *(const LAS bf16x8*)(lds + ATT_QOFF + qrow * 128 + (((4 * qc + ch) ^ ((qrow >> 1) & 7)) << 4));
#pragma unroll
            for (int e = 0; e < 8; ++e) { const float f = __uint_as_float(((unsigned)(unsigned short)v[e]) << 16); qs += f * f; } }
#pragma unroll
        for (int of = 1; of < 64; of <<= 1) qs = __builtin_fmaxf(qs, __shfl_xor(qs, of));
        LAS float* red = (LAS float*)(lds + ATT_QOFF + 32768);
        if (lane == 0) red[wid] = qs;
        __syncthreads();
        float q2 = red[0];
#pragma unroll
        for (int w = 1; w < 8; ++w) q2 = __builtin_fmaxf(q2, red[w]);
        const float k2 = __uint_as_float(__hip_atomic_load(kmax + b * 8 + h, __ATOMIC_RELAXED, __HIP_MEMORY_SCOPE_AGENT));
        const float X = sqrtf(q2 * k2) * 1.02f;
        const float Df = (ATT_SKIP_T + 2.0f * X) / slope2;
        const int D = Df < 8192.f ? (int)Df + 1 : 8192;
        nL = min(tq, (D + 62) >> 6); nR = min(60 - tq, ((D - 2) >> 6) + 1);
        nL = __builtin_amdgcn_readfirstlane(nL); nR = __builtin_amdgcn_readfirstlane(nR);
    }
    const int NT = 4 + nL + nR;
    ATT_DMA_TILE(attn_tile_of(1, tq, nL), ATT_TILE);
    float tb = kb0 + (float)(tq * 64);
#pragma unroll
    for (int r = 0; r < 16; ++r) cb0[r] = -slope2 * __builtin_fabsf(tb + (float)((r & 3) + 8 * (r >> 2)));
    attn_qk(sA, lds, ql, kofA, cb0, true, tb, slope2, 0.f, 0.f);
    int bcur = 0;
#pragma unroll 1
    for (int idx = 0; idx < NT; ++idx) {
        const int bnxt = (bcur == 2 * ATT_TILE) ? 0 : bcur + ATT_TILE, bnn = (bnxt == 2 * ATT_TILE) ? 0 : bnxt + ATT_TILE;
        asm volatile("s_waitcnt vmcnt(0)" ::: "memory");
        __syncthreads();
        if (idx + 2 < NT) ATT_DMA_TILE(attn_tile_of(idx + 2, tq, nL), bnn);
        const float delta = (idx < 4 + nL) ? 32.f * slope2 : -32.f * slope2;
        u32x4 pf[4];
        s16x4 vlo[8], vhi[8];
        attn_qk(sB, lds + bcur, ql, kofB, cb0, idx < 4, tb, slope2, mref, delta);
        __builtin_amdgcn_sched_barrier(0);
        if (VAR != 5) attn_vload(vlo, vhi, (unsigned)(bcur + vrb));
        attn_softmax<VAR>(sA, pf, sB, cb0, o, mref, lrow, lrow[0], idx == 0);
        asm volatile("s_waitcnt lgkmcnt(0)" ::: "memory"); __builtin_amdgcn_sched_barrier(0);
        if (VAR != 4 && VAR != 5) attn_pv(o[0], pf, vlo, vhi); else { asm volatile("" :: "v"(pf[0]), "v"(pf[1]), "v"(pf[2]), "v"(pf[3])); }
        const bool nform = (idx + 1 <= 4) || (idx + 1 == 4 + nL);
        if (nform) {
            tb = kb0 + (float)(attn_tile_of(idx + 1, tq, nL) * 64);
#pragma unroll
            for (int r = 0; r < 16; ++r) cb0[r] = -slope2 * __builtin_fabsf(tb + (float)((r & 3) + 8 * (r >> 2))) - mref;
        } else {
#pragma unroll
            for (int r = 0; r < 16; ++r) cb0[r] += step;
        }
        const float deltan = (idx + 1 < 4 + nL) ? 32.f * slope2 : -32.f * slope2;
        if (idx + 1 < NT) attn_qk(sA, lds + bnxt, ql, kofA, cb0, idx + 1 < 4, tb, slope2, mref, deltan);
        __builtin_amdgcn_sched_barrier(0);
        if (VAR != 5) attn_vload(vlo, vhi, (unsigned)(bcur + vrb));
        attn_softmax<VAR>(sB, pf, sA, cb0, o, mref, lrow, lrow[1], false);
        asm volatile("s_waitcnt lgkmcnt(0)" ::: "memory"); __builtin_amdgcn_sched_barrier(0);
        if (VAR != 4 && VAR != 5) attn_pv(o[1], pf, vlo, vhi); else { asm volatile("" :: "v"(pf[0]), "v"(pf[1]), "v"(pf[2]), "v"(pf[3])); }
        bcur = bnxt;
    }
    float inv[2];
#pragma unroll
    for (int c = 0; c < 2; ++c) { const float lt = lrow[c] + __shfl_xor(lrow[c], 32); inv[c] = 1.0f / lt; }
    const float w1 = lam * inv[1];
    float ss = 0.f;
#pragma unroll
    for (int d = 0; d < 2; ++d)
#pragma unroll
        for (int r = 0; r < 16; ++r) { const float v = o[0][d][r] * inv[0] - o[1][d][r] * w1; o[0][d][r] = v; ss += v * v; }
    ss += __shfl_xor(ss, 32);
    const float sc = oscale / sqrtf(ss * (1.0f / 64.0f) + SUBLN_EPS);
    bf16_t* orow = AF + (rowbase + q0 + r32) * 1024 + h * 64;
#pragma unroll
    for (int d = 0; d < 2; ++d)
#pragma unroll
        for (int g4 = 0; g4 < 4; ++g4) { const int dc = 32 * d + 8 * g4 + 4 * hi; const f32x4 gg = *(const f32x4*)(subg + dc);
            u32x2 w; w.x = pg8::cvt_pk_bf16(o[0][d][4 * g4] * sc * gg[0], o[0][d][4 * g4 + 1] * sc * gg[1]); w.y = pg8::cvt_pk_bf16(o[0][d][4 * g4 + 2] * sc * gg[2], o[0][d][4 * g4 + 3] * sc * gg[3]);
            *(u32x2*)(orow + dc) = w; }
    __syncthreads();
#undef ATT_DMA_TILE
}

constexpr int FFT_TAB = 65536;
__device__ __forceinline__ void fft_tables(LAS unsigned char* lds, const int wave_id) {
    int lane_ = __builtin_amdgcn_mbcnt_hi(~0u, __builtin_amdgcn_mbcnt_lo(~0u, 0u)); asm volatile("" : "+v"(lane_));
    const int tid = wave_id * 64 + lane_;
    for (int e = tid; e < 4096; e += NTHREADS) { const int row = e >> 6, col = e & 63; const float a = (float)((row * col) & 63) * (1.0f / 64.0f);
        const int off = row * 128 + ((((col >> 3) ^ ((row >> 1) & 7)) << 4) | ((col & 7) << 1));
        *(LAS bf16_t*)(lds + FFT_TAB + off) = (bf16_t)f2bf(__builtin_amdgcn_cosf(a)); *(LAS bf16_t*)(lds + FFT_TAB + 8192 + off) = (bf16_t)f2bf(__builtin_amdgcn_sinf(a)); }
}
__device__ __forceinline__ bf16x8 fft_tr8(unsigned addr) {
    s16x4 lo, hi;
    asm volatile("ds_read_b64_tr_b16 %0, %1" : "=v"(lo) : "v"(addr));
    asm volatile("ds_read_b64_tr_b16 %0, %1 offset:256" : "=v"(hi) : "v"(addr));
    asm volatile("s_waitcnt lgkmcnt(0)" ::: "memory");
    return (bf16x8){lo[0], lo[1], lo[2], lo[3], hi[0], hi[1], hi[2], hi[3]};
}
__device__ __forceinline__ void fft_item(int b, int co, const bf16_t* XT, bf16_t* AF, LAS unsigned char* lds, const int wave_id) {
    int lane_ = __builtin_amdgcn_mbcnt_hi(~0u, __builtin_amdgcn_mbcnt_lo(~0u, 0u)); asm volatile("" : "+v"(lane_));
    const int wid = wave_id, lane = lane_, tid = wid * 64 + lane, r32 = lane & 31, hi = lane >> 5;
    const bf16_t* src = XT + ((size_t)(b * 512 + co * 8 + wid) * 2) * SEQ;
    LAS unsigned char* wl = lds + wid * 8192;
    f32x16 yr[2][2], ym[2][2];
#pragma unroll
    for (int rb = 0; rb < 2; ++rb)
#pragma unroll
        for (int cb = 0; cb < 2; ++cb)
#pragma unroll
            for (int r = 0; r < 16; ++r) { yr[rb][cb][r] = 0.f; ym[rb][cb][r] = 0.f; }
    const int tsw = (r32 >> 1) & 7;
#pragma unroll
    for (int rb = 0; rb < 2; ++rb) {
#pragma unroll
        for (int part = 0; part < 2; ++part)
#pragma unroll
            for (int i = 0; i < 4; ++i)
                __builtin_amdgcn_global_load_lds((const unsigned*)(src + part * SEQ + 64 * (16 * i + (lane >> 2)) + 32 * rb + 8 * (lane & 3)), (LAS unsigned*)(wl + part * 4096 + i * 1024), 16, 0, 0);
        asm volatile("s_waitcnt vmcnt(0)" ::: "memory");
        const unsigned abase = (unsigned)(wid * 8192) + (8 * hi + ((lane & 15) >> 2)) * 64 + ((lane >> 4) & 1) * 32 + (lane & 3) * 8;
#pragma unroll
        for (int ks = 0; ks < 4; ++ks) {
            const bf16x8 ac = fft_tr8(abase + ks * 1024), as = fft_tr8(abase + 4096 + ks * 1024);
            const u32x4 asu = __builtin_bit_cast(u32x4, as); const bf16x8 an = __builtin_bit_cast(bf16x8, (u32x4){asu.x ^ 0x80008000u, asu.y ^ 0x80008000u, asu.z ^ 0x80008000u, asu.w ^ 0x80008000u});
#pragma unroll
            for (int cb = 0; cb < 2; ++cb) {
                const int toff = (32 * cb + r32) * 128 + (((2 * ks + hi) ^ tsw) << 4);
                const bf16x8 tc = *(const LAS bf16x8*)(lds + FFT_TAB + toff), ts = *(const LAS bf16x8*)(lds + FFT_TAB + 8192 + toff);
                yr[rb][cb] = __builtin_amdgcn_mfma_f32_32x32x16_bf16(ac, tc, yr[rb][cb], 0, 0, 0);
                yr[rb][cb] = __builtin_amdgcn_mfma_f32_32x32x16_bf16(an, ts, yr[rb][cb], 0, 0, 0);
                ym[rb][cb] = __builtin_amdgcn_mfma_f32_32x32x16_bf16(ac, ts, ym[rb][cb], 0, 0, 0);
                ym[rb][cb] = __builtin_amdgcn_mfma_f32_32x32x16_bf16(as, tc, ym[rb][cb], 0, 0, 0);
            }
        }
    }
    u32x4 pr[2][2][2], pm[2][2][2];
#pragma unroll
    for (int rb = 0; rb < 2; ++rb)
#pragma unroll
        for (int cb = 0; cb < 2; ++cb) {
            const int cp = 32 * cb + r32; float vr[16], vm[16];
#pragma unroll
            for (int r = 0; r < 16; ++r) { const int bp = 32 * rb + (r & 3) + 8 * (r >> 2) + 4 * hi; const float a = (float)((bp * cp) & 4095) * (1.0f / 4096.0f);
                const float cs = __builtin_amdgcn_cosf(a) * 0.015625f, sn = __builtin_amdgcn_sinf(a) * 0.015625f;
                vr[r] = yr[rb][cb][r] * cs - ym[rb][cb][r] * sn; vm[r] = -(yr[rb][cb][r] * sn + ym[rb][cb][r] * cs); }
#pragma unroll
            for (int s2 = 0; s2 < 2; ++s2) {
                pr[rb][cb][s2] = (u32x4){pg8::cvt_pk_bf16(vr[8 * s2], vr[8 * s2 + 1]), pg8::cvt_pk_bf16(vr[8 * s2 + 2], vr[8 * s2 + 3]), pg8::cvt_pk_bf16(vr[8 * s2 + 4], vr[8 * s2 + 5]), pg8::cvt_pk_bf16(vr[8 * s2 + 6], vr[8 * s2 + 7])};
                pm[rb][cb][s2] = (u32x4){pg8::cvt_pk_bf16(vm[8 * s2], vm[8 * s2 + 1]), pg8::cvt_pk_bf16(vm[8 * s2 + 2], vm[8 * s2 + 3]), pg8::cvt_pk_bf16(vm[8 * s2 + 4], vm[8 * s2 + 5]), pg8::cvt_pk_bf16(vm[8 * s2 + 6], vm[8 * s2 + 7])}; }
        }
    f32x16 out[2][2];
#pragma unroll
    for (int db = 0; db < 2; ++db)
#pragma unroll
        for (int cb = 0; cb < 2; ++cb)
#pragma unroll
            for (int r = 0; r < 16; ++r) out[db][cb][r] = 0.f;
#pragma unroll
    for (int db = 0; db < 2; ++db)
#pragma unroll
        for (int rb = 0; rb < 2; ++rb)
#pragma unroll
            for (int s2 = 0; s2 < 2; ++s2) {
                const int rowo = (32 * db + r32) * 128 + 8 * hi;
                typedef unsigned u32x2v __attribute__((ext_vector_type(2)));
                const u32x2v c0 = *(const LAS u32x2v*)(lds + FFT_TAB + rowo + (((4 * rb + 2 * s2) ^ tsw) << 4)), c1 = *(const LAS u32x2v*)(lds + FFT_TAB + rowo + (((4 * rb + 2 * s2 + 1) ^ tsw) << 4));
                const u32x2v s0 = *(const LAS u32x2v*)(lds + FFT_TAB + 8192 + rowo + (((4 * rb + 2 * s2) ^ tsw) << 4)), s1 = *(const LAS u32x2v*)(lds + FFT_TAB + 8192 + rowo + (((4 * rb + 2 * s2 + 1) ^ tsw) << 4));
                const bf16x8 fc = __builtin_bit_cast(bf16x8, (u32x4){c0.x, c0.y, c1.x, c1.y}), fs = __builtin_bit_cast(bf16x8, (u32x4){s0.x, s0.y, s1.x, s1.y});
#pragma unroll
                for (int cb = 0; cb < 2; ++cb) {
                    out[db][cb] = __builtin_amdgcn_mfma_f32_32x32x16_bf16(fc, __builtin_bit_cast(bf16x8, pr[rb][cb][s2]), out[db][cb], 0, 0, 0);
                    out[db][cb] = __builtin_amdgcn_mfma_f32_32x32x16_bf16(fs, __builtin_bit_cast(bf16x8, pm[rb][cb][s2]), out[db][cb], 0, 0, 0);
                }
            }
    __syncthreads();
#pragma unroll
    for (int db = 0; db < 2; ++db)
#pragma unroll
        for (int cb = 0; cb < 2; ++cb)
#pragma unroll
            for (int r = 0; r < 16; ++r) { const int so = 32 * cb + r32 + 64 * (32 * db + (r & 3) + 8 * (r >> 2) + 4 * hi);
                *(LAS bf16_t*)(lds + so * 16 + wid * 2) = (bf16_t)f2bf(out[db][cb][r]); }
    __syncthreads();
#pragma unroll
    for (int i = 0; i < 8; ++i) { const int so = i * 512 + tid; const u32x4 v = *(const LAS u32x4*)(lds + so * 16);
        *(u32x4*)(AF + ((size_t)b * SEQ + so) * 1024 + 512 + co * 8) = v; }
    __syncthreads();
}

#define RLX_AGENT __ATOMIC_RELAXED, __HIP_MEMORY_SCOPE_AGENT
constexpr int CW_KMAX = 1024;
constexpr int CW_BAR = 4096;
#define XB_TMO      128
#define XB_XCNT(j)  (256  + 64 * (j))
#define XB_XSUB(j)  (1280 + 64 * (j))
#define XB_XGEN(j)  (2304 + 64 * (j))
#define XB_TOP      3328
#define XB_TOPGEN   3392
#define XCD_BAR_WORDS 3456
#define XB_SPIN_CAP (1u << 18)

__device__ __forceinline__ unsigned xb_ld(unsigned* p)              { return __hip_atomic_load(p, __ATOMIC_RELAXED, __HIP_MEMORY_SCOPE_AGENT); }
__device__ __forceinline__ unsigned xb_add(unsigned* p, unsigned v) { return __hip_atomic_fetch_add(p, v, __ATOMIC_RELAXED, __HIP_MEMORY_SCOPE_AGENT); }
__device__ __forceinline__ unsigned xb_xcc_id() { return (unsigned)__builtin_amdgcn_s_getreg((3 << 11) | 20) & 0xFu; }
#define XB_SPIN(cond, bar) do { unsigned _sp = 0; while (cond) { __builtin_amdgcn_s_sleep(1); \
    if ((++_sp & 255u) == 0u) { if (xb_ld(&(bar)[XB_TMO])) break; if (_sp > XB_SPIN_CAP) { atomicAdd(&(bar)[XB_TMO], 1u); break; } } } } while (0)

struct XcdBarrier {
    unsigned* bar; unsigned x;
    volatile LAS unsigned* st;
};

__device__ __forceinline__ XcdBarrier xcd_barrier_post(unsigned* bar, volatile LAS unsigned* st, bool t0) {
    XcdBarrier b; b.bar = bar; b.x = xb_xcc_id(); b.st = st;
    if (t0) (void)xb_add(&bar[XB_XCNT(b.x)], 1u);
    return b;
}
__device__ __forceinline__ void xcd_barrier_complete(unsigned* bar, unsigned x, unsigned& nloc, unsigned& nx) {
    const unsigned G = gridDim.x * gridDim.y * gridDim.z;
    unsigned sum, cnt, mine, sp = 0u;
    for (;;) {
        sum = 0u; cnt = 0u; mine = 0u;
#pragma unroll
        for (unsigned j = 0; j < 16; ++j) { const unsigned c = xb_ld(&bar[XB_XCNT(j)]); sum += c; cnt += (c > 0u) ? 1u : 0u; mine = (j == x) ? c : mine; }
        if (sum == G) break;
        __builtin_amdgcn_s_sleep(1);
        if ((++sp & 255u) == 0u) { if (xb_ld(&bar[XB_TMO])) break; if (sp > XB_SPIN_CAP) { atomicAdd(&bar[XB_TMO], 1u); break; } }
    }
    nloc = mine > 0u ? mine : 1u; nx = cnt > 0u ? cnt : 1u;
}

__device__ __forceinline__ void xcd_barrier(const XcdBarrier& b, bool t0) {
    asm volatile("s_waitcnt vmcnt(0)" ::: "memory");
    __syncthreads();
    if (t0) {
        unsigned* bar = b.bar;
        __builtin_amdgcn_s_waitcnt(0);
        unsigned nloc = b.st[0], nx = b.st[1];
        if (nloc == 0u) { xcd_barrier_complete(bar, b.x, nloc, nx); b.st[0] = nloc; b.st[1] = nx; }
        const unsigned old = xb_add(&bar[XB_XSUB(b.x)], 1u);
        const unsigned gen = old / nloc;
        if (old + 1u == (gen + 1u) * nloc) {
            __builtin_amdgcn_fence(__ATOMIC_RELEASE, "agent");
            asm volatile("s_waitcnt vmcnt(0)" ::: "memory");
            const unsigned og = xb_add(&bar[XB_TOP], 1u);
            const unsigned tg = og / nx;
            if (og + 1u == (tg + 1u) * nx) xb_add(&bar[XB_TOPGEN], 1u);
            else XB_SPIN(xb_ld(&bar[XB_TOPGEN]) == tg, bar);
            __builtin_amdgcn_fence(__ATOMIC_ACQUIRE, "agent");
            xb_add(&bar[XB_XGEN(b.x)], 1u);
            asm volatile("s_waitcnt vmcnt(0)" ::: "memory");
        } else {
            XB_SPIN(xb_ld(&bar[XB_XGEN(b.x)]) == gen, bar);
            __builtin_amdgcn_fence(__ATOMIC_ACQUIRE, "agent");
            asm volatile("s_waitcnt vmcnt(0)" ::: "memory");
        }
    }
    __syncthreads();
}


__device__ __forceinline__ int lane_id_fresh() { int l = __builtin_amdgcn_mbcnt_hi(~0u, __builtin_amdgcn_mbcnt_lo(~0u, 0u)); asm volatile("" : "+v"(l)); return l; }
__device__ __forceinline__ void* karg_ptr(int idx) {
    const __attribute__((address_space(4))) char* p = (const __attribute__((address_space(4))) char*)__builtin_amdgcn_kernarg_segment_ptr();
    asm volatile("" : "+s"(p));
    return *(void* const __attribute__((address_space(4)))*)(p + 8 * idx);
}
#ifndef PH_MASK
#define PH_MASK 0xFFFF
#endif
#define PH(k) if constexpr ((PH_MASK >> (k)) & 1)
#ifndef REP_MASK
#define REP_MASK 0
#endif
#define REP(k) for (int rep_ = 0; rep_ < ((((REP_MASK) >> (k)) & 1) ? 2 : 1); ++rep_)
#define GRID_SYNC_CG() do { __threadfence(); grid.sync(); } while (0)
#define THREAD0() (wave_s == 0 && lane_id_fresh() == 0)
#define GRID_SYNC() do { XcdBarrier bar_; bar_.bar = (unsigned*)(ws + WS_CTL) + CW_BAR; bar_.x = xb_xcc_id(); bar_.st = (volatile LAS unsigned*)(lds + 131072) + 8; xcd_barrier(bar_, THREAD0()); } while (0)
__global__ void __launch_bounds__(NTHREADS, 2) fwd_megakernel(Args args) {
    extern __shared__ __attribute__((aligned(16))) unsigned char lds_raw[];
    cg::grid_group grid = cg::this_grid();
    LAS unsigned char* lds = (LAS unsigned char*)lds_raw;
    const int wave_s = __builtin_amdgcn_readfirstlane(threadIdx.x >> 6);
    constexpr int G = 256;
    const int bx = blockIdx.x & 255;
    const int vcu = (bx % 8) * (G / 8) + bx / 8;
    const int NGW = G * NWAVES;
#define LANE_VARS int lane_ = __builtin_amdgcn_mbcnt_hi(~0u, __builtin_amdgcn_mbcnt_lo(~0u, 0u)); asm volatile("" : "+v"(lane_)); const int lane = lane_, wave = wave_s, tid = wave * 64 + lane, gw = vcu * NWAVES + wave; (void)tid; (void)lane; (void)gw;
#define KARG(i) (karg_ptr(i))
#define ws ((unsigned char*)KARG(16))
#define x_in ((const float*)KARG(0))
#define ln_in_g ((const float*)KARG(1))
#define ln_in_b ((const float*)KARG(2))
#define w_in ((const float*)KARG(3))
#define lam_params ((const float*)KARG(4))
#define subln_g ((const float*)KARG(5))
#define w_f ((const float*)KARG(6))
#define b_f ((const float*)KARG(7))
#define w_o ((const float*)KARG(8))
#define ln1_g ((const float*)KARG(9))
#define ln1_b ((const float*)KARG(10))
#define w_gu ((const float*)KARG(11))
#define w_down ((const float*)KARG(12))
#define ln2_g ((const float*)KARG(13))
#define ln2_b ((const float*)KARG(14))
#define PRE ((float*)KARG(15))
#define XN ((bf16_t*)(ws + WS_XN))
#define AF XN
#define H ((float*)(ws + WS_H))
#define QKV ((bf16_t*)(ws + WS_QKV))
#define XT ((bf16_t*)(ws + WS_XT))
#define ACT ((bf16_t*)(ws + WS_ACT))
    (void)args;
    volatile LAS unsigned* MISC = (volatile LAS unsigned*)(lds + 131072);
    if (wave_s == 0) MISC[lane_id_fresh()] = 0u;
    __syncthreads();
    (void)xcd_barrier_post((unsigned*)(ws + WS_CTL) + CW_BAR, MISC + 8, THREAD0());

    PH(0) REP(0) {
        LANE_VARS
        LAS float* scr = (LAS float*)(lds + wave * 8704);
        LAS float* tabc = (LAS float*)(lds + 8 * 8704); LAS float* tabs = tabc + 128;
        if (tid < 128) { const float a = (float)tid * (1.0f / 128.0f); tabc[tid] = __builtin_amdgcn_cosf(a) * 0.08838834764831845f; tabs[tid] = __builtin_amdgcn_sinf(a) * 0.08838834764831845f; }
        __syncthreads();
        constexpr int I_QKV = 16 * 48, I_O = 8 * 32, I_GU = 16 * 176, I_D = 44 * 32, I_L = I_QKV + I_O + I_GU + I_D;
        for (int it = gw; it < DEPTH * I_L; it += NGW) {
            const int l = it / I_L; int r = it % I_L; unsigned char* wl = ws + WS_W + (size_t)l * W_LAYER;
            if (r < I_QKV) { const int kb = r / 48, nb = r % 48; tr_item(w_in + (size_t)l * DM * 2048, 2048, (bf16_t*)(wl + W_QKV), DM, 64 * kb, 32 * nb, 0, nb < 16 ? QSCALE : 1.0f, scr, lane); continue; } r -= I_QKV;
            if (r < I_O) { const int kb = r / 32, nb = r % 32; tr_item(w_o + (size_t)l * DM * DM, DM, (bf16_t*)(wl + W_O), DM, 64 * kb, 32 * nb, 0, 1.0f, scr, lane); continue; } r -= I_O;
            if (r < I_GU) { const int kb = r / 176, nb = r % 176; tr_item(w_gu + (size_t)l * DM * NGU, NGU, (bf16_t*)(wl + W_GU), DM, 64 * kb, 32 * nb, 1, 1.0f, scr, lane); continue; } r -= I_GU;
            { const int kb = r / 32, nb = r % 32; tr_item(w_down + (size_t)l * FF * DM, DM, (bf16_t*)(wl + W_D), FF, 64 * kb, 32 * nb, 0, 1.0f, scr, lane); }
        }
        for (int it = gw; it < DEPTH * 1024; it += NGW) {
            const int l = it >> 10, r = it & 1023, g = r >> 8, kb = (r >> 4) & 15, cb = r & 15;
            const float* src = w_in + (size_t)l * DM * 2048 + (size_t)(64 * kb + lane) * 2048 + 1536 + 128 * g;
            float ac[8], as[8];
#pragma unroll
            for (int j = 0; j < 8; ++j) { ac[j] = 0.f; as[j] = 0.f; }
            for (int c4 = 0; c4 < 32; ++c4) { const f32x4 w = *(const f32x4*)(src + 4 * c4);
#pragma unroll
                for (int e = 0; e < 4; ++e) { const int c = 4 * c4 + e;
#pragma unroll
                    for (int j = 0; j < 8; ++j) { const int idx = (c * (8 * cb + j)) & 127; ac[j] += w[e] * tabc[idx]; as[j] += w[e] * tabs[idx]; } } }
            bf16_t* dst = (bf16_t*)(ws + WS_W + (size_t)l * W_LAYER + W_U);
#pragma unroll
            for (int j = 0; j < 8; ++j) { const int ch = 128 * g + 8 * cb + j;
                dst[(size_t)(2 * ch) * DM + 64 * kb + lane] = (bf16_t)f2bf(ac[j]); dst[(size_t)(2 * ch + 1) * DM + 64 * kb + lane] = (bf16_t)f2bf(as[j]); }
        }
        for (int it = gw; it < DEPTH * 1024; it += NGW) {
            const int l = it >> 10, r = it & 1023, g = r >> 8, nb = (r >> 4) & 15, cb = r & 15;
            const float* wo = w_o + (size_t)l * DM * DM + (size_t)(512 + 128 * g) * DM + 64 * nb + lane;
            const float* wf = w_f + (size_t)l * 4 * 128 * 128 + (size_t)g * 128 * 128 + (size_t)(8 * cb) * 128;
            float a8[8];
#pragma unroll
            for (int j = 0; j < 8; ++j) a8[j] = 0.f;
            for (int d = 0; d < 128; ++d) { const float w = wo[(size_t)d * DM];
#pragma unroll
                for (int j = 0; j < 8; ++j) a8[j] += wf[j * 128 + d] * w; }
            u32x4 o; o.x = pk2(a8[0], a8[1]); o.y = pk2(a8[2], a8[3]); o.z = pk2(a8[4], a8[5]); o.w = pk2(a8[6], a8[7]);
            *(u32x4*)((bf16_t*)(ws + WS_W + (size_t)l * W_LAYER + W_O) + (size_t)(64 * nb + lane) * DM + 512 + 128 * g + 8 * cb) = o;
        }
        for (int it = gw; it < DEPTH * 16; it += NGW) {
            const int l = it >> 4, nb = it & 15; const float* wo = w_o + (size_t)l * DM * DM + (size_t)512 * DM + 64 * nb + lane; const float* bf = b_f + l * 512;
            float a = 0.f; for (int j = 0; j < 512; ++j) a += bf[j] * wo[(size_t)j * DM];
            ((float*)(ws + WS_W + (size_t)l * W_LAYER + W_BO))[64 * nb + lane] = a;
        }
        for (int m = gw; m < MTOK; m += NGW) ln_row(x_in + (size_t)m * DM, ln_in_g, ln_in_b, H + (size_t)m * DM, XN + (size_t)m * DM, lane);
    }

#ifdef BENCH_KIND
    {
        float a[16];
#pragma unroll
        for (int k = 0; k < 16; ++k) a[k] = 0.001f * (float)(threadIdx.x + k);
#pragma unroll 1
        for (int it = 0; it < 8192; ++it) {
#pragma unroll
            for (int k = 0; k < 16; ++k) {
#if BENCH_KIND == 1
                asm volatile("v_fma_f32 %0, %0, %1, %2" : "+v"(a[k]) : "v"(0.999f), "v"(0.0005f));
#else
                asm volatile("v_exp_f32 %0, %0" : "+v"(a[k]));
#endif
            }
        }
        float t = 0.f;
#pragma unroll
        for (int k = 0; k < 16; ++k) t += a[k];
        if (t == 12345.678f) ((float*)(ws + WS_CTL))[8192 + threadIdx.x] = t;
    }
#endif
    GRID_SYNC_CG();

#pragma unroll 1
    for (int l = 0; l < DEPTH; ++l) {
        unsigned char* wl = ws + WS_W + (size_t)l * W_LAYER;
        const bf16_t* Wqkv_t = (const bf16_t*)(wl + W_QKV); const bf16_t* Wu_t = (const bf16_t*)(wl + W_U); const bf16_t* Wo_t = (const bf16_t*)(wl + W_O);
        const bf16_t* Wgu_t = (const bf16_t*)(wl + W_GU); const bf16_t* Wd_t = (const bf16_t*)(wl + W_D); const float* bias_o = (const float*)(wl + W_BO);
        PH(1) REP(1) { pg8::Gemm g{XN, Wqkv_t, MTOK, NQKV, DM}; pg8::StaticOrder S; S.init(MTOK, NQKV, G, bx);
          pg8::EpiQKV E{QKV, (unsigned*)(ws + WS_CTL) + CW_KMAX + l * 64};
          pg8::gemm_phase<pg8::EpiQKV, pg8::StaticOrder, true, true>(lds, g, S, E, wave_s); }
        PH(2) REP(2) { pg8::Gemm g{Wu_t, XN, NU2, MTOK, DM}; pg8::StaticOrder S; S.init(NU2, MTOK, G, bx);
          pg8::EpiBf16 E{XT, SEQ, SEQ, (size_t)NU2 * SEQ};
          pg8::gemm_phase<pg8::EpiBf16, pg8::StaticOrder, true, true>(lds, g, S, E, wave_s); }
        GRID_SYNC();
        PH(3) REP(3) {
            const float* lp = lam_params + l * 128; float d01 = 0.f, d23 = 0.f;
            for (int i = 0; i < 32; ++i) { d01 += lp[i] * lp[32 + i]; d23 += lp[64 + i] * lp[96 + i]; }
            const float lam_init = 0.8f - 0.6f * expf(-0.3f * (float)l);
            const float lam = expf(d01) - expf(d23) + lam_init;
            const unsigned* kmaxl = (const unsigned*)(ws + WS_CTL) + CW_KMAX + l * 64;
            if (G == 256) {
                for (int i = 0; i < 4; ++i) { const int hs = (vcu >> 4) & 1; const int hh = hs ? (i == 0 ? 1 : i == 1 ? 6 : i == 2 ? 2 : 5) : (i == 0 ? 0 : i == 1 ? 7 : i == 2 ? 3 : 4);
                    const int qq = (i & 1) ? 15 - (vcu & 15) : (vcu & 15);
                    attn_unit<0>(vcu >> 5, hh, qq, QKV, AF, lam, 1.0f - lam_init, subln_g + l * 64, kmaxl, lds, wave_s); }
            } else {
                for (int u = vcu; u < BATCH * NHEAD * 16; u += G) attn_unit<0>(u >> 7, (u >> 4) & 7, u & 15, QKV, AF, lam, 1.0f - lam_init, subln_g + l * 64, kmaxl, lds, wave_s);
            }
        }
        PH(4) REP(4) { fft_tables(lds, wave_s); __syncthreads();
          for (int it = vcu; it < BATCH * 64; it += G) fft_item(it >> 6, it & 63, XT, AF, lds, wave_s); }
        GRID_SYNC();
        PH(5) REP(5) { pg8::Gemm g{AF, Wo_t, MTOK, DM, DM}; pg8::StaticOrder S; S.init(MTOK, DM, G, bx);
          pg8::EpiPre E{H, PRE, bias_o, ALPHA};
          pg8::gemm_phase<pg8::EpiPre, pg8::StaticOrder, true, true>(lds, g, S, E, wave_s); }
        GRID_SYNC();
        PH(6) REP(6) { LANE_VARS for (int m = gw; m < MTOK; m += NGW) ln_row(PRE + (size_t)m * DM, ln1_g + l * DM, ln1_b + l * DM, H + (size_t)m * DM, XN + (size_t)m * DM, lane); }
        GRID_SYNC();
        PH(7) REP(7) { pg8::Gemm g{XN, Wgu_t, MTOK, NGU, DM}; pg8::StaticOrder S; S.init(MTOK, NGU, G, bx);
          pg8::EpiSwiGLU E{ACT, FF};
          pg8::gemm_phase<pg8::EpiSwiGLU, pg8::StaticOrder, true, true>(lds, g, S, E, wave_s); }
        GRID_SYNC();
        PH(8) REP(8) { pg8::Gemm g{ACT, Wd_t, MTOK, DM, FF}; pg8::StaticOrder S; S.init(MTOK, DM, G, bx);
          pg8::EpiPre E{H, PRE, nullptr, ALPHA};
          pg8::gemm_phase<pg8::EpiPre, pg8::StaticOrder, true, true>(lds, g, S, E, wave_s); }
        GRID_SYNC();
        PH(9) { LANE_VARS const bool last = (l == DEPTH - 1);
          for (int m = gw; m < MTOK; m += NGW) ln_row(PRE + (size_t)m * DM, ln2_g + l * DM, ln2_b + l * DM, last ? PRE + (size_t)m * DM : H + (size_t)m * DM, XN + (size_t)m * DM, lane); }
        if (l + 1 < DEPTH) GRID_SYNC();
    }
}

#undef ws
#undef x_in
#undef PRE
#undef XN
#undef AF
#undef H
#undef QKV
#undef XT
#undef ACT
constexpr int LDS_BYTES = 147456;
extern "C" void kernel_launch(void* const* d_in, const int* in_sizes, int n_in, void* d_out, int out_size, void* d_ws, size_t ws_size, hipStream_t stream) {
    static int grid = 0;
    if (grid == 0) {
        if (n_in != 15 || out_size != MTOK * DM || ws_size < WS_END) { fprintf(stderr, "kernel_launch: unexpected problem (n_in %d, out %d, ws %zu)\n", n_in, out_size, ws_size); grid = -1; return; }
        int dev = 0, cus = 0, per_cu = 0;
        hipGetDevice(&dev); hipDeviceGetAttribute(&cus, hipDeviceAttributeMultiprocessorCount, dev);
        hipFuncSetAttribute((const void*)fwd_megakernel, hipFuncAttributeMaxDynamicSharedMemorySize, LDS_BYTES);
        hipOccupancyMaxActiveBlocksPerMultiprocessor(&per_cu, (const void*)fwd_megakernel, NTHREADS, LDS_BYTES);
        if (per_cu < 1) { fprintf(stderr, "kernel_launch: occupancy query says %d blocks per CU\n", per_cu); grid = -1; return; }
        if (cus != 256) { fprintf(stderr, "kernel_launch: built for a 256-CU device, found %d CUs\n", cus); grid = -1; return; }
        grid = cus;
        (void)hipGetLastError();
    }
    if (grid < 0) return;
    if (hipMemsetAsync((char*)d_ws + WS_CTL, 0, 65536, stream) != hipSuccess) { fprintf(stderr, "kernel_launch: memset failed\n"); return; }
    Args a{};
    for (int i = 0; i < 15; ++i) a.in[i] = (const float*)d_in[i];
    a.out = (float*)d_out; a.ws = (unsigned char*)d_ws;
    void* kargs[] = {&a};
    hipError_t e = hipLaunchCooperativeKernel((const void*)fwd_megakernel, dim3(grid), dim3(NTHREADS), kargs, LDS_BYTES, stream);
    if (e != hipSuccess) fprintf(stderr, "cooperative launch failed: %s (grid %d)\n", hipGetErrorString(e), grid);
}
```
